# Optimizing an MI355X kernel written in HIP

```python
import math
import jax, jax.numpy as jnp
from jax import lax
import numpy as np

D_MODEL = 1024
BATCH = 2
SEQ = 16384
DEPTH = 4

GRID_W = 64
CTX_LEN = 256
HEAD_DIM = 64
ROPE_THETA = 10000.0
Q_BLOCK = 128
EPS = 1e-6
N_MOD = 6
DIFF_HEADS = 4
DIFF_QK_DIM = HEAD_DIM
DIFF_V_DIM = 2 * HEAD_DIM
GQA_Q_HEADS = 8
GQA_KV_HEADS = 2
GQA_GROUP = GQA_Q_HEADS // GQA_KV_HEADS
ATTN_IN = DIFF_HEADS * (4 * DIFF_QK_DIM + DIFF_V_DIM) + (GQA_Q_HEADS + 2 * GQA_KV_HEADS) * HEAD_DIM
ATTN_OUT = DIFF_HEADS * DIFF_V_DIM + GQA_Q_HEADS * HEAD_DIM
SGU_DIM = D_MODEL
SGU_GROUPS = 4
SGU_CHUNK = 128
FFN_DIM = 2816
CONV_W = 3
N_EVEN = (DEPTH + 1) // 2
N_ODD = DEPTH // 2

kernel_name = "hybrid_diffattn_gqa_sgu_convffn_dit"


def rms_norm(x, g):
    xf = x.astype(jnp.float32)
    y = xf * lax.rsqrt(jnp.mean(xf * xf, axis=-1, keepdims=True) + EPS)
    return (y * g.astype(jnp.float32)).astype(x.dtype)


def modulate(h, shift, scale):
    return h * (1 + scale) + shift


def axial_rope_tables(rows):
    n_freq = HEAD_DIM // 4
    inv = ROPE_THETA ** (-jnp.arange(n_freq, dtype=jnp.float32) / n_freq)
    row = jnp.repeat(jnp.arange(rows, dtype=jnp.float32), GRID_W)
    col = jnp.tile(jnp.arange(GRID_W, dtype=jnp.float32), rows)
    ang = jnp.concatenate([row[:, None] * inv, col[:, None] * inv], axis=-1)
    return jnp.cos(ang), jnp.sin(ang)


def apply_rope(x, cos, sin):
    xf = x.astype(jnp.float32).reshape(x.shape[:-1] + (x.shape[-1] // 2, 2))
    x0, x1 = xf[..., 0], xf[..., 1]
    c = cos[None, :, None, :]
    s = sin[None, :, None, :]
    out = jnp.stack([x0 * c - x1 * s, x0 * s + x1 * c], axis=-1).reshape(x.shape)
    return out.astype(x.dtype)


def attn_project(h, w_in, q_norm, k_norm, rope):
    B, S, _ = h.shape
    qk_a = DIFF_HEADS * DIFF_QK_DIM
    sizes = [qk_a, qk_a, qk_a, qk_a, DIFF_HEADS * DIFF_V_DIM,
             GQA_Q_HEADS * HEAD_DIM, GQA_KV_HEADS * HEAD_DIM, GQA_KV_HEADS * HEAD_DIM]
    splits = [int(v) for v in np.cumsum(sizes)[:-1]]
    q1, q2, k1, k2, va, qb, kb, vb = jnp.split(h @ w_in, splits, axis=-1)
    heads = lambda t, n: t.reshape(B, S, n, -1)
    q1, q2, k1, k2, va = (heads(t, DIFF_HEADS) for t in (q1, q2, k1, k2, va))
    qb = rms_norm(heads(qb, GQA_Q_HEADS), q_norm)
    kb = rms_norm(heads(kb, GQA_KV_HEADS), k_norm)
    vb = heads(vb, GQA_KV_HEADS)
    if rope is not None:
        cos, sin = rope
        q1, q2, k1, k2, qb, kb = (apply_rope(t, cos, sin) for t in (q1, q2, k1, k2, qb, kb))
    return q1, q2, qb, k1, k2, va, kb, vb


def diff_attend(q1, q2, k1, k2, v, lam):
    scale = DIFF_QK_DIM ** -0.5
    p1 = jax.nn.softmax(jnp.einsum('bqhd,bkhd->bhqk', q1, k1).astype(jnp.float32) * scale, axis=-1)
    p2 = jax.nn.softmax(jnp.einsum('bqhd,bkhd->bhqk', q2, k2).astype(jnp.float32) * scale, axis=-1)
    p = (p1 - lam * p2).astype(v.dtype)
    return jnp.einsum('bhqk,bkhv->bqhv', p, v)


def gqa_attend(q, k, v):
    B, Q, H, d = q.shape
    qg = q.reshape(B, Q, GQA_KV_HEADS, GQA_GROUP, d)
    s = jnp.einsum('bqgrd,bkgd->bgrqk', qg, k).astype(jnp.float32) * (d ** -0.5)
    p = jax.nn.softmax(s, axis=-1).astype(v.dtype)
    return jnp.einsum('bgrqk,bkgd->bqgrd', p, v).reshape(B, Q, H, d)


def attn_heads(q1, q2, qb, k1, k2, va, kb, vb, lam, lam_init, subln):
    B, Q = q1.shape[:2]
    oa = rms_norm(diff_attend(q1, q2, k1, k2, va, lam), subln) * (1 - lam_init)
    ob = gqa_attend(qb, kb, vb)
    return jnp.concatenate([oa.reshape(B, Q, -1), ob.reshape(B, Q, -1)], axis=-1)


def sweep_query_blocks(fn, qs):
    B, S = qs[0].shape[:2]
    nb = S // Q_BLOCK
    blocks = tuple(jnp.moveaxis(q.reshape((B, nb, Q_BLOCK) + q.shape[2:]), 1, 0) for q in qs)
    out = lax.map(lambda qb: fn(*qb), blocks)
    return jnp.moveaxis(out, 0, 1).reshape(B, S, out.shape[-1])


def attention_mixer(h_lat, h_ctx, w_in, w_out, lq1, lk1, lq2, lk2, subln, q_norm, k_norm,
                    lam_init, rope, with_ctx_out):
    lat = attn_project(h_lat, w_in, q_norm, k_norm, rope)
    ctx = attn_project(h_ctx, w_in, q_norm, k_norm, None)
    lam = (jnp.exp(jnp.sum(lq1.astype(jnp.float32) * lk1.astype(jnp.float32)))
           - jnp.exp(jnp.sum(lq2.astype(jnp.float32) * lk2.astype(jnp.float32))) + lam_init)
    K1, K2, VA, KB, VB = (jnp.concatenate([ctx[i], lat[i]], axis=1) for i in range(3, 8))
    lat_fn = lambda q1b, q2b, qbb: attn_heads(q1b, q2b, qbb, K1, K2, VA, KB, VB, lam, lam_init, subln)
    y_lat = sweep_query_blocks(lat_fn, lat[:3]) @ w_out
    y_ctx = None
    if with_ctx_out:
        y_ctx = attn_heads(*ctx, lam, lam_init, subln) @ w_out
    return y_lat, y_ctx


def sgu_mixer(h, w_in, v_norm, w_s, b_s, w_out):
    B, S, _ = h.shape
    z = jax.nn.gelu(h @ w_in, approximate=False)
    u, v = jnp.split(z, 2, axis=-1)
    v = rms_norm(v, v_norm)
    n = S // SGU_CHUNK
    vg = v.reshape(B, n, SGU_CHUNK, SGU_GROUPS, SGU_DIM // SGU_GROUPS)
    mixed = jnp.einsum('gpq,bnqgc->bnpgc', w_s, vg) + b_s.T[:, :, None]
    return (u * mixed.reshape(B, S, SGU_DIM)) @ w_out


def conv_ffn(h, w_up, conv_w, conv_b, w_down):
    S = h.shape[1]
    z = h @ w_up
    zp = jnp.pad(z, ((0, 0), (1, 1), (0, 0)))
    z = conv_w[0] * zp[:, :S] + conv_w[1] * zp[:, 1:S + 1] + conv_w[2] * zp[:, 2:] + conv_b
    g, u = jnp.split(z, 2, axis=-1)
    return (jax.nn.silu(g) * u) @ w_down


def setup_inputs(seed: int = 0) -> dict:
    key = jax.random.key(seed)
    ks = iter(jax.random.split(key, 32))
    D = D_MODEL
    nrm = lambda shape, s: jax.random.normal(next(ks), shape, jnp.float32) * s
    return {
        "x": nrm((BATCH, SEQ, D), 1.0),
        "c": nrm((BATCH, D), 1.0),
        "ctx": nrm((BATCH, CTX_LEN, D), 1.0),
        "c_ctx": nrm((D,), 1.0),
        "ada_w": nrm((DEPTH, D, N_MOD * D), 0.5 * D ** -0.5),
        "ada_b": nrm((DEPTH, N_MOD * D), 0.02),
        "mix_norm": 1.0 + nrm((DEPTH, D), 0.1),
        "ffn_norm": 1.0 + nrm((DEPTH, D), 0.1),
        "final_norm": 1.0 + nrm((D,), 0.1),
        "attn_w_in": nrm((N_EVEN, D, ATTN_IN), D ** -0.5),
        "attn_w_out": nrm((N_EVEN, ATTN_OUT, D), ATTN_OUT ** -0.5),
        "diff_lq1": nrm((N_EVEN, DIFF_QK_DIM), 0.1),
        "diff_lk1": nrm((N_EVEN, DIFF_QK_DIM), 0.1),
        "diff_lq2": nrm((N_EVEN, DIFF_QK_DIM), 0.1),
        "diff_lk2": nrm((N_EVEN, DIFF_QK_DIM), 0.1),
        "diff_subln": 1.0 + nrm((N_EVEN, DIFF_V_DIM), 0.1),
        "gqa_q_norm": 1.0 + nrm((N_EVEN, HEAD_DIM), 0.1),
        "gqa_k_norm": 1.0 + nrm((N_EVEN, HEAD_DIM), 0.1),
        "sgu_w_in": nrm((N_ODD, D, 2 * SGU_DIM), D ** -0.5),
        "sgu_v_norm": 1.0 + nrm((N_ODD, SGU_DIM), 0.1),
        "sgu_w_s": nrm((N_ODD, SGU_GROUPS, SGU_CHUNK, SGU_CHUNK), SGU_CHUNK ** -0.5),
        "sgu_b_s": 1.0 + nrm((N_ODD, SGU_GROUPS, SGU_CHUNK), 0.1),
        "sgu_w_out": nrm((N_ODD, SGU_DIM, D), SGU_DIM ** -0.5),
        "ffn_w_up": nrm((DEPTH, D, 2 * FFN_DIM), D ** -0.5),
        "ffn_conv_w": nrm((DEPTH, CONV_W, 2 * FFN_DIM), CONV_W ** -0.5),
        "ffn_conv_b": nrm((DEPTH, 2 * FFN_DIM), 0.02),
        "ffn_w_down": nrm((DEPTH, FFN_DIM, D), FFN_DIM ** -0.5),
    }


def reference(x, c, ctx, c_ctx, ada_w, ada_b, mix_norm, ffn_norm, final_norm,
              attn_w_in, attn_w_out, diff_lq1, diff_lk1, diff_lq2, diff_lk2, diff_subln,
              gqa_q_norm, gqa_k_norm, sgu_w_in, sgu_v_norm, sgu_w_s, sgu_b_s, sgu_w_out,
              ffn_w_up, ffn_conv_w, ffn_conv_b, ffn_w_down):
    rows = x.shape[1] // GRID_W
    rope = axial_rope_tables(rows)
    last_attn = (DEPTH - 1) // 2 * 2
    s_c = jax.nn.silu(c)
    s_cc = jax.nn.silu(c_ctx)
    for l in range(DEPTH):
        i = l // 2
        is_attn = l % 2 == 0
        update_ctx = l < last_attn
        m_lat = (s_c @ ada_w[l] + ada_b[l])[:, None, :]
        sh1, sc1, g1, sh2, sc2, g2 = jnp.split(m_lat, N_MOD, axis=-1)
        h_lat = modulate(rms_norm(x, mix_norm[l]), sh1, sc1)
        if is_attn or update_ctx:
            m_ctx = s_cc @ ada_w[l] + ada_b[l]
            csh1, csc1, cg1, csh2, csc2, cg2 = jnp.split(m_ctx, N_MOD, axis=-1)
            h_ctx = modulate(rms_norm(ctx, mix_norm[l]), csh1, csc1)
        if is_attn:
            lam_init = 0.8 - 0.6 * math.exp(-0.3 * l)
            y_lat, y_ctx = attention_mixer(h_lat, h_ctx, attn_w_in[i], attn_w_out[i],
                                           diff_lq1[i], diff_lk1[i], diff_lq2[i], diff_lk2[i],
                                           diff_subln[i], gqa_q_norm[i], gqa_k_norm[i],
                                           lam_init, rope, update_ctx)
        else:
            y_lat = sgu_mixer(h_lat, sgu_w_in[i], sgu_v_norm[i], sgu_w_s[i], sgu_b_s[i], sgu_w_out[i])
            if update_ctx:
                y_ctx = sgu_mixer(h_ctx, sgu_w_in[i], sgu_v_norm[i], sgu_w_s[i], sgu_b_s[i], sgu_w_out[i])
        x = x + g1 * y_lat
        x = x + g2 * conv_ffn(modulate(rms_norm(x, ffn_norm[l]), sh2, sc2),
                              ffn_w_up[l], ffn_conv_w[l], ffn_conv_b[l], ffn_w_down[l])
        if update_ctx:
            ctx = ctx + cg1 * y_ctx
            ctx = ctx + cg2 * conv_ffn(modulate(rms_norm(ctx, ffn_norm[l]), csh2, csc2),
                                       ffn_w_up[l], ffn_conv_w[l], ffn_conv_b[l], ffn_w_down[l])
    return rms_norm(x, final_norm)
```

```cpp
#include <hip/hip_runtime.h>
#include <hip/hip_bf16.h>
#include <hip/hip_cooperative_groups.h>
#include <cstdio>
#include <cstdint>
#include <cmath>
namespace cg = cooperative_groups;
namespace pg8 {
#define PG8_LAS __attribute__((address_space(3)))
typedef unsigned short bf16_t;
typedef short bf16x8 __attribute__((ext_vector_type(8)));
typedef float f32x4 __attribute__((ext_vector_type(4)));
typedef unsigned u32x4 __attribute__((ext_vector_type(4)));
constexpr int BM = 256, BK = 64, HALF = 128, HTB = HALF * BK * 2  , STAGE_BYTES = 8 * HTB, NXCD = 8, WGM = 4;

__host__ __device__ __forceinline__ int lds_byte(int r, int c) { const int st = (r >> 4) * 2 + (c >> 5), rr = r & 15, cc = c & 31, ob = rr * 64 + cc * 2; return st * 1024 + (ob ^ (((ob >> 9) & 1) << 5)); }
__host__ __device__ __forceinline__ void stage_rc(int b, int& R, int& C) { const int st = b / 1024, sb = b % 1024, swz = sb ^ (((sb >> 9) & 1) << 5); R = (st >> 1) * 16 + swz / 64; C = (st & 1) * 32 + (swz % 64) / 2; }
__host__ __device__ __forceinline__ int perm32(int rho) { const int n = rho >> 4, i = rho & 15; return 8 * (i >> 2) + 4 * n + (i & 3); }

struct Unit { int pm, pn; };
struct Gemm { const bf16_t* A; const bf16_t* Bt; int M, N, K; };

struct StaticOrder {
    int nM, nN, nwg, G, c, wgm;
    __host__ __device__ void init(int M, int N, int G_, int c_, int wgm_ = WGM) { nM = M / BM; nN = N / BM; nwg = nM * nN; G = G_; c = c_; wgm = wgm_; }
    __host__ __device__ bool next(int i, Unit& u) const {
        const long L = (long)i * G + c; if (L >= nwg) return false;
        int wgid = (int)L; { const int q = nwg / NXCD, r = nwg % NXCD, xcd = wgid % NXCD, off = wgid / NXCD; wgid = (xcd < r ? xcd * (q + 1) : r * (q + 1) + (xcd - r) * q) + off; }
        const int nig = wgm * nN, gid = wgid / nig, fm = gid * wgm, gsz = (nM - fm) < wgm ? (nM - fm) : wgm;
        u.pm = fm + ((wgid % nig) % gsz); u.pn = (wgid % nig) / gsz; return true;
    }
    __device__ __forceinline__ void a_ready(const Unit&) const {}
    __device__ __forceinline__ void done(const Unit&) const {}
};

__device__ __forceinline__ unsigned cvt_pk_bf16(float lo, float hi) { unsigned r; asm volatile("v_cvt_pk_bf16_f32 %0, %1, %2" : "=v"(r) : "v"(lo), "v"(hi)); return r; }
typedef float f32x2 __attribute__((ext_vector_type(2)));
__device__ __forceinline__ f32x2 gelu_pk(f32x2 v) {
    const f32x2 av = __builtin_elementwise_abs(v), d = av * 0.2316418882f + 1.0f;
    f32x2 t; t.x = __builtin_amdgcn_rcpf(d.x); t.y = __builtin_amdgcn_rcpf(d.y);
    f32x2 q = t * 0.5307027145f + (-0.7265760135f); q = q * t + 0.7107068705f; q = q * t + (-0.142248368f); q = q * t + 0.127414796f; q = q * t;
    const f32x2 s = (v * v) * (-0.72134752044f);
    f32x2 e; e.x = __builtin_amdgcn_exp2f(s.x); e.y = __builtin_amdgcn_exp2f(s.y);
    const f32x2 m = v * (q * e), r = v - m;
    f32x2 o; o.x = v.x < 0.f ? m.x : r.x; o.y = v.y < 0.f ? m.y : r.y; return o;
}

template <int ACT  > struct EpiBf16 {
    static constexpr bool PERM = true, AFTER_DRAIN = false; static_assert(ACT == 0 || ACT == 1, "EpiBf16: ACT is 0 (none) or 1 (gelu_pk)");
    bf16_t* O; int ldc; const float* bias; int split_cols; size_t split_stride; float scale0;
    __device__ __forceinline__ void operator()(const f32x4 (&acc)[2][2][4][2], const Unit& u, int wr, int wc, int fr, int fq) const {
        const int row0 = u.pm * BM + wr * 64 + fr; int colt = u.pn * BM; bf16_t* base = O;
        float sc = 1.f; if (split_cols) { const int t = colt / split_cols; base += (size_t)t * split_stride; colt -= t * split_cols; if (t == 0) sc = scale0; }
        const int col0 = colt + wc * 32 + 8 * fq, bcol0 = u.pn * BM + wc * 32 + 8 * fq;
        f32x4 bv[2][2];
#pragma unroll
        for (int bj = 0; bj < 2; ++bj)
#pragma unroll
            for (int n = 0; n < 2; ++n) bv[bj][n] = bias ? *(const f32x4*)(bias + bcol0 + bj * HALF + 4 * n) : (f32x4){0.f, 0.f, 0.f, 0.f};
#pragma unroll
        for (int ai = 0; ai < 2; ++ai)
#pragma unroll
            for (int m = 0; m < 4; ++m) { bf16_t* rowp = base + (size_t)(row0 + ai * HALF + m * 16) * ldc + col0;
#pragma unroll
                for (int bj = 0; bj < 2; ++bj) { f32x4 v0 = acc[ai][bj][m][0] + bv[bj][0], v1 = acc[ai][bj][m][1] + bv[bj][1];
                    if (ACT == 1) { f32x2 a = gelu_pk((f32x2){v0[0], v0[1]}), b = gelu_pk((f32x2){v0[2], v0[3]}), c = gelu_pk((f32x2){v1[0], v1[1]}), d = gelu_pk((f32x2){v1[2], v1[3]});
                        v0 = (f32x4){a.x, a.y, b.x, b.y}; v1 = (f32x4){c.x, c.y, d.x, d.y}; }
                    v0 = v0 * sc; v1 = v1 * sc; u32x4 w; w.x = cvt_pk_bf16(v0[0], v0[1]); w.y = cvt_pk_bf16(v0[2], v0[3]); w.z = cvt_pk_bf16(v1[0], v1[1]); w.w = cvt_pk_bf16(v1[2], v1[3]);
                    *(u32x4*)(rowp + bj * HALF) = w; } }
    }
};
template <class Epi, class Sched, bool ALIGN_EPI = false, bool SP2 = false>
__device__ __forceinline__ void gemm_phase(PG8_LAS unsigned char* lds, const Gemm g, const Sched& S, const Epi& E) {
    int tid_ = threadIdx.x; asm volatile("" : "+v"(tid_));
    const int tid = tid_, wid = __builtin_amdgcn_readfirstlane(tid >> 6), lane = tid & 63, wr = wid >> 2, wc = wid & 3, fr = lane & 15, fq = lane >> 4;
    const int K = g.K, nt = K / BK;
    unsigned voffA[2], voffB[2];
#pragma unroll
    for (int i = 0; i < 2; ++i) { int R, C; stage_rc(tid * 16 + i * 8192, R, C); const int Rb = Epi::PERM ? ((R & ~31) + perm32(R & 31)) : R;
        voffA[i] = (unsigned)(R * K + C) * 2u; voffB[i] = (unsigned)(Rb * K + C) * 2u; }
    const size_t kstep = (size_t)(BK * 2);
    const size_t hstep = (size_t)HALF * K * 2;
    const size_t tstep = 2 * hstep;
    const unsigned ldsw = (unsigned)wid * 1024u;
    const int aoff = lds_byte(wr * 64 + fr, fq * 8), boff = lds_byte(wc * 32 + fr, fq * 8);
#define PG8_SA(b, h) (((b) * 2 + (h)) * HTB)
#define PG8_SB(b, h) ((4 + (b) * 2 + (h)) * HTB)
#define PG8_STAGE(bufoff, gbase, voff) do { _Pragma("unroll") for (int _i = 0; _i < 2; ++_i) \
        __builtin_amdgcn_global_load_lds((const unsigned*)((const char*)(gbase) + (voff)[_i]), (PG8_LAS unsigned*)(lds + (bufoff) + ldsw + _i * 8192), 16, 0, 0); } while (0)
#define PG8_LDA(dst, b, h) do { _Pragma("unroll") for (int m = 0; m < 4; ++m) _Pragma("unroll") for (int k = 0; k < 2; ++k) dst[m][k] = *(const PG8_LAS bf16x8*)(lds + PG8_SA(b, h) + aoff + m * 2048 + k * 1024); } while (0)
#define PG8_LDB(dst, b, h) do { _Pragma("unroll") for (int n = 0; n < 2; ++n) _Pragma("unroll") for (int k = 0; k < 2; ++k) dst[n][k] = *(const PG8_LAS bf16x8*)(lds + PG8_SB(b, h) + boff + n * 2048 + k * 1024); } while (0)
#define PG8_MMA(ai, bj, At, Bt) do { __builtin_amdgcn_s_setprio(1); _Pragma("unroll") for (int m = 0; m < 4; ++m) _Pragma("unroll") for (int n = 0; n < 2; ++n) _Pragma("unroll") for (int k = 0; k < 2; ++k) \
        acc[ai][bj][m][n] = __builtin_amdgcn_mfma_f32_16x16x32_bf16(Bt[n][k], At[m][k], acc[ai][bj][m][n], 0, 0, 0); __builtin_amdgcn_s_setprio(0); } while (0)
#define PG8_WAIT_V(n) asm volatile("s_waitcnt vmcnt(" #n ")" ::: "memory")
#define PG8_WAIT_L(n) asm volatile("s_waitcnt lgkmcnt(" #n ")" ::: "memory")
#define PG8_BAR __builtin_amdgcn_s_barrier()
#define PG8_SCHED __builtin_amdgcn_sched_barrier(0)
    Unit cur, nxt; int ui = 0;
    if (!S.next(0, cur)) return;
    f32x4 acc[2][2][4][2];
#pragma unroll
    for (int a = 0; a < 2; ++a)
#pragma unroll
        for (int b = 0; b < 2; ++b)
#pragma unroll
            for (int m = 0; m < 4; ++m)
#pragma unroll
                for (int n = 0; n < 2; ++n) acc[a][b][m][n] = (f32x4){0.f, 0.f, 0.f, 0.f};
    bf16x8 At[4][2], B0[2][2], B1[2][2];
    const char* cA = (const char*)g.A + (size_t)cur.pm * tstep; const char* cB = (const char*)g.Bt + (size_t)cur.pn * tstep;
    S.a_ready(cur);
    if constexpr (SP2) {
        PG8_STAGE(PG8_SB(0, 0), cB, voffB); PG8_STAGE(PG8_SB(0, 1), cB + hstep, voffB); PG8_STAGE(PG8_SA(0, 0), cA, voffA); PG8_STAGE(PG8_SA(0, 1), cA + hstep, voffA);
        if (wr == 1) PG8_BAR;
        PG8_WAIT_V(2); PG8_BAR;
        PG8_STAGE(PG8_SB(1, 0), cB + kstep, voffB); PG8_STAGE(PG8_SA(1, 0), cA + kstep, voffA); PG8_STAGE(PG8_SB(1, 1), cB + hstep + kstep, voffB);
        PG8_WAIT_V(6); PG8_BAR;
    } else {
        PG8_STAGE(PG8_SB(0, 0), cB, voffB); PG8_STAGE(PG8_SA(0, 0), cA, voffA); PG8_STAGE(PG8_SB(0, 1), cB + hstep, voffB); PG8_STAGE(PG8_SA(0, 1), cA + hstep, voffA);
        if (wr == 1) PG8_BAR;
        PG8_WAIT_V(4); PG8_BAR;
        PG8_STAGE(PG8_SB(1, 0), cB + kstep, voffB); PG8_STAGE(PG8_SA(1, 0), cA + kstep, voffA); PG8_STAGE(PG8_SB(1, 1), cB + hstep + kstep, voffB);
        PG8_WAIT_V(6); PG8_BAR;
    }
    for (;;) {
        const bool has_next = S.next(ui + 1, nxt);
        const char* nA = has_next ? (const char*)g.A + (size_t)nxt.pm * tstep : cA; const char* nB = has_next ? (const char*)g.Bt + (size_t)nxt.pn * tstep : cB;
        for (int t = 0; t < nt; t += 2) {
            const bool last = (t == nt - 2);
            const char* a1 = cA + (size_t)(t + 1) * kstep;
            const char* a2 = last ? nA : cA + (size_t)(t + 2) * kstep; const char* b2 = last ? nB : cB + (size_t)(t + 2) * kstep;
            const char* a3 = a2 + kstep; const char* b3 = b2 + kstep;
            if (last && has_next) S.a_ready(nxt);
            if constexpr (SP2) {
            PG8_LDB(B0, 0, 0); PG8_LDB(B1, 0, 1); PG8_SCHED; PG8_LDA(At, 0, 0); PG8_STAGE(PG8_SA(1, 1), a1 + hstep, voffA);
            PG8_WAIT_V(8); PG8_WAIT_L(0); PG8_BAR; PG8_MMA(0, 0, At, B0); PG8_MMA(0, 1, At, B1); PG8_BAR; PG8_SCHED;
            PG8_LDA(At, 0, 1); PG8_STAGE(PG8_SB(0, 0), b2, voffB); PG8_STAGE(PG8_SB(0, 1), b2 + hstep, voffB); PG8_STAGE(PG8_SA(0, 0), a2, voffA);
            PG8_WAIT_V(8); PG8_WAIT_L(0); PG8_BAR; PG8_MMA(1, 0, At, B0); PG8_MMA(1, 1, At, B1); PG8_BAR; PG8_SCHED;
            PG8_LDB(B0, 1, 0); PG8_LDB(B1, 1, 1); PG8_SCHED; PG8_LDA(At, 1, 0); PG8_STAGE(PG8_SA(0, 1), a2 + hstep, voffA);
            PG8_WAIT_V(8); PG8_WAIT_L(0); PG8_BAR; PG8_MMA(0, 0, At, B0); PG8_MMA(0, 1, At, B1); PG8_BAR; PG8_SCHED;
            PG8_LDA(At, 1, 1); PG8_STAGE(PG8_SB(1, 0), b3, voffB); PG8_STAGE(PG8_SB(1, 1), b3 + hstep, voffB); PG8_STAGE(PG8_SA(1, 0), a3, voffA);
            PG8_WAIT_V(8); PG8_WAIT_L(0); PG8_BAR; PG8_MMA(1, 0, At, B0); PG8_MMA(1, 1, At, B1); PG8_BAR; PG8_SCHED;
            } else {
            PG8_LDB(B0, 0, 0); PG8_SCHED; PG8_LDA(At, 0, 0); PG8_STAGE(PG8_SA(1, 1), a1 + hstep, voffA);
            PG8_WAIT_L(8); PG8_BAR; PG8_WAIT_L(0); PG8_MMA(0, 0, At, B0); PG8_BAR; PG8_SCHED;
            PG8_LDB(B1, 0, 1); PG8_STAGE(PG8_SB(0, 0), b2, voffB);
            PG8_BAR; PG8_WAIT_L(0); PG8_MMA(0, 1, At, B1); PG8_BAR;
            PG8_LDA(At, 0, 1); PG8_STAGE(PG8_SA(0, 0), a2, voffA);
            PG8_BAR; PG8_WAIT_L(0); PG8_MMA(1, 0, At, B0); PG8_BAR; PG8_SCHED;
            PG8_STAGE(PG8_SB(0, 1), b2 + hstep, voffB);
            PG8_WAIT_V(6); PG8_BAR; PG8_MMA(1, 1, At, B1); PG8_BAR;
            PG8_LDB(B0, 1, 0); PG8_SCHED; PG8_LDA(At, 1, 0); PG8_STAGE(PG8_SA(0, 1), a2 + hstep, voffA);
            PG8_WAIT_L(8); PG8_BAR; PG8_WAIT_L(0); PG8_MMA(0, 0, At, B0); PG8_BAR; PG8_SCHED;
            PG8_LDB(B1, 1, 1); PG8_STAGE(PG8_SB(1, 0), b3, voffB);
            PG8_BAR; PG8_WAIT_L(0); PG8_MMA(0, 1, At, B1); PG8_BAR;
            PG8_LDA(At, 1, 1); PG8_STAGE(PG8_SA(1, 0), a3, voffA);
            PG8_BAR; PG8_WAIT_L(0); PG8_MMA(1, 0, At, B0); PG8_BAR; PG8_SCHED;
            PG8_STAGE(PG8_SB(1, 1), b3 + hstep, voffB);
            PG8_WAIT_V(6); PG8_BAR; PG8_MMA(1, 1, At, B1); PG8_BAR;
            }
        }
        if constexpr (ALIGN_EPI) { if (wr == 0) PG8_BAR; }
        if constexpr (!Epi::AFTER_DRAIN) { E(acc, cur, wr, wc, fr, fq); S.done(cur); }
        if (!has_next) break;
#pragma unroll
        for (int a = 0; a < 2; ++a)
#pragma unroll
            for (int b = 0; b < 2; ++b)
#pragma unroll
                for (int m = 0; m < 4; ++m)
#pragma unroll
                    for (int n = 0; n < 2; ++n) acc[a][b][m][n] = (f32x4){0.f, 0.f, 0.f, 0.f};
        cur = nxt; cA = nA; cB = nB; ++ui;
        if constexpr (ALIGN_EPI) { if (wr == 1) PG8_BAR; }
    }
    PG8_WAIT_V(0);
    if constexpr (!ALIGN_EPI) { if (wr == 0) PG8_BAR; }
    PG8_BAR;
    if constexpr (Epi::AFTER_DRAIN) { E.fused(acc, cur, wr, wc, fr, fq, lds, wid, lane); S.done(cur); }
#undef PG8_SA
#undef PG8_SB
#undef PG8_STAGE
#undef PG8_LDA
#undef PG8_LDB
#undef PG8_MMA
#undef PG8_WAIT_V
#undef PG8_WAIT_L
#undef PG8_BAR
#undef PG8_SCHED
}
}
#include <hip/hip_bf16.h>
namespace attn_body {
using bf16=__hip_bfloat16;
using bf16x8=__attribute__((ext_vector_type(8)))short;
using s16x4=__attribute__((ext_vector_type(4)))short;
using f32x16=__attribute__((ext_vector_type(16)))float;
using u32x4=__attribute__((ext_vector_type(4)))unsigned;
constexpr int D=64,PQ=2304,PO=1536;
constexpr int NW=8,QBLK=32,QB=QBLK*NW,KVBLK=64;
__device__ __forceinline__ int crow(int r,int hi){return (r&3)+8*(r>>2)+4*hi;}
#define SBAR() __builtin_amdgcn_sched_barrier(0)
__device__ __forceinline__ void cmask(f32x16&p0,f32x16&p1,int jb,int qrel,int hi){
  const float NEG=-INFINITY; int kb=64*jb+4*hi;
  #pragma unroll
  for(int r=0;r<16;++r){int kv=kb+(r&3)+8*(r>>2); if(kv>qrel)p0[r]=NEG; if(kv+32>qrel)p1[r]=NEG;}
}

constexpr int NSLOT=3, SLOTB=8192;
constexpr int LDS_K=0, LDS_V=NSLOT*SLOTB, LDS_WS=2*NSLOT*SLOTB, LDS_OST=LDS_WS+NW*64*4, LDS_BYTES=LDS_OST+NW*4096;
constexpr float C2=0.125f*1.4426950408889634f;
__device__ __forceinline__ void glds16(const void*gsrc,unsigned lds_dst){unsigned keep;
  asm volatile("s_mov_b32 %0, m0\n\ts_mov_b32 m0, %2\n\ts_nop 0\n\tglobal_load_lds_dwordx4 %1, off\n\ts_mov_b32 m0, %0":"=&s"(keep):"v"(gsrc),"s"(lds_dst):"memory");}
__device__ __forceinline__ float max3f(float a,float b,float c){float r;asm("v_max3_f32 %0, %1, %2, %3":"=v"(r):"v"(a),"v"(b),"v"(c));return r;}
__device__ __forceinline__ float max2f(float a,float b){float r;asm("v_max_f32_e32 %0, %1, %2":"=v"(r):"v"(a),"v"(b));return r;}
__device__ __forceinline__ float fadd_s(float a,float b){float r;asm("v_add_f32_e32 %0, %1, %2":"=v"(r):"v"(a),"v"(b));return r;}
__device__ __forceinline__ float fsub_s(float a,float b){float r;asm("v_sub_f32_e32 %0, %1, %2":"=v"(r):"v"(a),"v"(b));return r;}
typedef float f32x2_t __attribute__((ext_vector_type(2))); typedef __bf16 bf16x2_t __attribute__((ext_vector_type(2)));
__device__ __forceinline__ unsigned cvtpk_s(float lo,float hi){f32x2_t v={lo,hi};bf16x2_t b=__builtin_convertvector(v,bf16x2_t);return __builtin_bit_cast(unsigned,b);}
#define WAIT_BAR(N) asm volatile("s_waitcnt vmcnt(" #N ") lgkmcnt(0)\n\ts_barrier":::"memory")

__device__ __forceinline__ void qkt(f32x16&p0,f32x16&p1,const char*Kslot,const bf16x8*qr,const f32x16&negm,int r32,int hi){
  const char*kb=Kslot+hi*1024+r32*16;
  #pragma unroll
  for(int d0=0;d0<4;++d0){
    const bf16x8 b0=*reinterpret_cast<const bf16x8*>(kb+d0*2048);
    const bf16x8 b1=*reinterpret_cast<const bf16x8*>(kb+d0*2048+512);
    if(d0==0){p0=__builtin_amdgcn_mfma_f32_32x32x16_bf16(b0,qr[0],negm,0,0,0);p1=__builtin_amdgcn_mfma_f32_32x32x16_bf16(b1,qr[0],negm,0,0,0);}
    else{p0=__builtin_amdgcn_mfma_f32_32x32x16_bf16(b0,qr[d0],p0,0,0,0);p1=__builtin_amdgcn_mfma_f32_32x32x16_bf16(b1,qr[d0],p1,0,0,0);}}
}
typedef __attribute__((address_space(3))) const char* lds_cptr;
typedef short v4i16_t __attribute__((ext_vector_type(4)));
__device__ __forceinline__ void kload8(bf16x8*kf,lds_cptr kp){
  kf[0]=*(const __attribute__((address_space(3))) bf16x8*)(kp);      kf[1]=*(const __attribute__((address_space(3))) bf16x8*)(kp+512);
  kf[2]=*(const __attribute__((address_space(3))) bf16x8*)(kp+2048); kf[3]=*(const __attribute__((address_space(3))) bf16x8*)(kp+2560);
  kf[4]=*(const __attribute__((address_space(3))) bf16x8*)(kp+4096); kf[5]=*(const __attribute__((address_space(3))) bf16x8*)(kp+4608);
  kf[6]=*(const __attribute__((address_space(3))) bf16x8*)(kp+6144); kf[7]=*(const __attribute__((address_space(3))) bf16x8*)(kp+6656);
}
__device__ __forceinline__ void kload2(bf16x8*kf,lds_cptr kp,int j){ kf[2*j]=*(const __attribute__((address_space(3))) bf16x8*)(kp+j*2048); kf[2*j+1]=*(const __attribute__((address_space(3))) bf16x8*)(kp+j*2048+512); }
__device__ __forceinline__ s16x4 vtr(lds_cptr p){ return __builtin_bit_cast(s16x4,__builtin_amdgcn_ds_read_tr16_b64_v4i16((__attribute__((address_space(3))) v4i16_t*)p)); }
__device__ __forceinline__ float rowmax(const f32x16&p0,const f32x16&p1){
  float a=max3f(p0[0],p0[1],p1[0]),b=max3f(p0[2],p0[3],p1[1]);a=max3f(a,p1[2],p1[3]);
  #pragma unroll
  for(int r=4;r<16;r+=4){a=max3f(a,p0[r],p0[r+1]);b=max3f(b,p0[r+2],p0[r+3]);a=max3f(a,p1[r],p1[r+1]);b=max3f(b,p1[r+2],p1[r+3]);}
  const float m=max2f(a,b);
  auto rr=__builtin_amdgcn_permlane32_swap(__float_as_uint(m),__float_as_uint(m),false,false);
  return max2f(__uint_as_float(rr[0]),__uint_as_float(rr[1]));
}
__device__ __forceinline__ void pv(f32x16*o,int vb,bf16x8 pa0,bf16x8 pa1,bf16x8 pa2,bf16x8 pa3){
  #pragma unroll
  for(int d0=0;d0<2;++d0){s16x4 lo[4],hi[4];
    #pragma unroll
    for(int ks=0;ks<4;++ks){
      asm volatile("ds_read_b64_tr_b16 %0,%1 offset:%c2":"=&v"(lo[ks]):"v"(vb),"i"(d0*4096+ks*1024):"memory");
      asm volatile("ds_read_b64_tr_b16 %0,%1 offset:%c2":"=&v"(hi[ks]):"v"(vb),"i"(d0*4096+ks*1024+512):"memory");}
    asm volatile("s_waitcnt lgkmcnt(0)":::"memory");SBAR();
    #define PK(k) (bf16x8){lo[k][0],lo[k][1],lo[k][2],lo[k][3],hi[k][0],hi[k][1],hi[k][2],hi[k][3]}
    o[d0]=__builtin_amdgcn_mfma_f32_32x32x16_bf16(pa0,PK(0),o[d0],0,0,0);
    o[d0]=__builtin_amdgcn_mfma_f32_32x32x16_bf16(pa1,PK(1),o[d0],0,0,0);
    o[d0]=__builtin_amdgcn_mfma_f32_32x32x16_bf16(pa2,PK(2),o[d0],0,0,0);
    o[d0]=__builtin_amdgcn_mfma_f32_32x32x16_bf16(pa3,PK(3),o[d0],0,0,0);
    #undef PK
  }
}

#ifndef ATTN_STORE16
#define ATTN_STORE16(p,v) (*(u32x4*)(p)=(v))
#endif
template<int THRL> __device__ __forceinline__ void attn_unit(const bf16*Qblk,const bf16*__restrict__ Kh,const bf16*__restrict__ Vh,bf16*Oblk,const int po,const int NT,char*shm){
  int tid_=threadIdx.x; asm volatile("":"+v"(tid_));
  const int tid=tid_,lane=tid&63,r32=lane&31,hi=lane>>5; const int wid=__builtin_amdgcn_readfirstlane(tid>>6);
  const bf16*Qw=Qblk+(long)wid*QBLK*PQ;
  const unsigned lds0=(unsigned)(uintptr_t)shm;
  float*wsf=(float*)(shm+LDS_WS)+wid*64;
  const bf16*ksrc=Kh+(long)lane*PQ+wid*8;
  const bf16*vsrc=Vh+(long)(16*(wid&3)+(lane>>2))*PQ+(wid>>2)*32+(lane&3)*8;
  const unsigned kdst=lds0+LDS_K+wid*1024, vdst=lds0+LDS_V+wid*1024;
  #define DMA_K(t,slot) glds16(ksrc+(long)(t)*KVBLK*PQ,(unsigned)__builtin_amdgcn_readfirstlane(kdst+(slot)))
  #define DMA_V(t,slot) glds16(vsrc+(long)(t)*KVBLK*PQ,(unsigned)__builtin_amdgcn_readfirstlane(vdst+(slot)))
  const int vb0=(int)(lds0+LDS_V)+((lane>>4)&1)*32+(lane&3)*8+(4*hi+((lane&15)>>2))*64;
  const char*Kbase=shm+LDS_K; bf16x8 kf[8];
  const lds_cptr shm3=(lds_cptr)shm; const lds_cptr kp0=shm3+LDS_K+hi*1024+r32*16; const lds_cptr vp0=shm3+LDS_V+((lane>>4)&1)*32+(lane&3)*8+(4*hi+((lane&15)>>2))*64;
  DMA_K(0,0);DMA_V(0,0);DMA_K(1,SLOTB);
  bf16x8 qr[4];
  #pragma unroll
  for(int d0=0;d0<4;++d0)qr[d0]=*reinterpret_cast<const bf16x8*>(&Qw[(long)r32*PQ+d0*16+hi*8]);
  float mhat=0.f,l_reg=0.f;f32x16 o[2];o[0]=f32x16{};o[1]=f32x16{};f32x16 negm=f32x16{};asm volatile("":"+v"(negm));
  #define CMASK(P0,P1,t) do{}while(0)
  bool resc=false;
  #define START(P0,P1) do{ const float rm=rowmax(P0,P1); resc=false; \
    { const float dl=rm; mhat=fadd_s(mhat,dl); \
      _Pragma("unroll") for(int r=0;r<16;++r){P0[r]=fsub_s(P0[r],dl);P1[r]=fsub_s(P1[r],dl);} \
      _Pragma("unroll") for(int r=0;r<16;++r)negm[r]=-mhat; asm volatile("":"+v"(negm)); } \
    _Pragma("unroll") for(int r=0;r<16;++r)P0[r]=__builtin_amdgcn_exp2f(P0[r]); }while(0)
  #define RESC() do{ if(resc){ asm volatile("s_waitcnt lgkmcnt(0)":::"memory"); \
      _Pragma("unroll") for(int d_=0;d_<2;++d_) _Pragma("unroll") for(int r=0;r<16;++r)o[d_][r]*=wsf[crow(r,hi)]; } }while(0)
  f32x16 pA0,pA1,pB0,pB1;
  int sl_prev=0,sl_cur=0,sl_next=SLOTB;
  #define ROT() do{sl_prev=sl_cur;sl_cur=sl_next;sl_next=(sl_next==(NSLOT-1)*SLOTB)?0:sl_next+SLOTB;}while(0)
  DMA_K(2,2*SLOTB);
  WAIT_BAR(3);
  qkt(pA0,pA1,Kbase,qr,negm,r32,hi);asm volatile("s_nop 15\n\ts_nop 7":"+v"(pA0),"+v"(pA1));CMASK(pA0,pA1,0);
  START(pA0,pA1);
  _Pragma("unroll") for(int r=0;r<16;++r)pA1[r]=__builtin_amdgcn_exp2f(pA1[r]);
  WAIT_BAR(0);
  DMA_K(3,0);DMA_V(1,SLOTB);
  ROT();
  kload8(kf,kp0+sl_cur);
  WAIT_BAR(2);
  s16x4 vlo[8],vhi[8]; u32x4 pw0,pw1,pw2,pw3;
  #define PKW(P,B) cvtpk_s(P[B],P[B+1])
  #define PAF(k) __builtin_bit_cast(bf16x8,pw##k)
  #define VFR(i) (bf16x8){vlo[i][0],vlo[i][1],vlo[i][2],vlo[i][3],vhi[i][0],vhi[i][1],vhi[i][2],vhi[i][3]}
  #define PIN(x) asm volatile("":"+v"(x))
  #define MX3(a,b,c) __builtin_fmaxf(__builtin_fmaxf((a),(b)),(c))
  #define GAPA(MF,A0,A1,A2,A3,W0,W1,PW) do{ MF; sacc+=A0; sacc+=A1; sacc+=A2; sacc+=A3; PIN(sacc); W0; W1; PIN(PW); SBAR(); }while(0)
  #define EX(v) __builtin_amdgcn_exp2f(v)
  #define GAPB(MF,X,B) do{ MF; X[B]=EX(X[B]); X[B+1]=EX(X[B+1]); X[B+2]=EX(X[B+2]); X[B+3]=EX(X[B+3]); PIN(X); SBAR(); }while(0)
  #define VRD(i) do{ vlo[i]=vtr(vp_+(((i)>>2)*4096+((i)&3)*1024)); vhi[i]=vtr(vp_+(((i)>>2)*4096+((i)&3)*1024+512)); }while(0)
  #define KRD(G,j) do{ if(G){ kload2(kf,kp0+sl_next,j); SBAR(); } }while(0)
  #define STEP(C0,C1,P0,P1,t,GK,GV,GL) do{ SBAR(); \
    const lds_cptr vp_=vp0+sl_prev; \
    VRD(0); SBAR(); float sacc=(P0[0]+P0[1]); \
    GAPA(C0=__builtin_amdgcn_mfma_f32_32x32x16_bf16(kf[0],qr[0],negm,0,0,0), P0[2],P0[3],P0[4],P0[5],     pw0[0]=PKW(P0,0), pw0[1]=PKW(P0,2), pw0); \
    VRD(4); SBAR(); GAPA(C1=__builtin_amdgcn_mfma_f32_32x32x16_bf16(kf[1],qr[0],negm,0,0,0), P0[6],P0[7],P0[8],P0[9],     pw0[2]=PKW(P0,4), pw0[3]=PKW(P0,6), pw0); \
    VRD(1); SBAR(); GAPA(C0=__builtin_amdgcn_mfma_f32_32x32x16_bf16(kf[2],qr[1],C0,0,0,0),   P0[10],P0[11],P0[12],P0[13], pw1[0]=PKW(P0,8), pw1[1]=PKW(P0,10), pw1); \
    VRD(5); SBAR(); GAPA(C1=__builtin_amdgcn_mfma_f32_32x32x16_bf16(kf[3],qr[1],C1,0,0,0),   P0[14],P0[15],P1[0],P1[1],   pw1[2]=PKW(P0,12),pw1[3]=PKW(P0,14), pw1); \
    VRD(2); SBAR(); GAPA(C0=__builtin_amdgcn_mfma_f32_32x32x16_bf16(kf[4],qr[2],C0,0,0,0),   P1[2],P1[3],P1[4],P1[5],     pw2[0]=PKW(P1,0), pw2[1]=PKW(P1,2), pw2); \
    VRD(6); SBAR(); GAPA(C1=__builtin_amdgcn_mfma_f32_32x32x16_bf16(kf[5],qr[2],C1,0,0,0),   P1[6],P1[7],P1[8],P1[9],     pw2[2]=PKW(P1,4), pw2[3]=PKW(P1,6), pw2); \
    VRD(3); SBAR(); GAPA(C0=__builtin_amdgcn_mfma_f32_32x32x16_bf16(kf[6],qr[3],C0,0,0,0),   P1[10],P1[11],P1[12],P1[13], pw3[0]=PKW(P1,8), pw3[1]=PKW(P1,10), pw3); \
    VRD(7); SBAR(); GAPA(C1=__builtin_amdgcn_mfma_f32_32x32x16_bf16(kf[7],qr[3],C1,0,0,0),   P1[14],P1[15],0.f,0.f,       pw3[2]=PKW(P1,12),pw3[3]=PKW(P1,14), pw3); \
    l_reg+=sacc; \
    if(GK){DMA_K((t)+3,sl_cur);} if(GV){DMA_V((t)+1,sl_next);} \
    CMASK(C0,C1,t); \
    { float a=MX3(C0[0],C0[1],C1[0]),b=MX3(C0[2],C0[3],C1[1]); a=MX3(a,C1[2],C1[3]); \
      _Pragma("unroll") for(int r=4;r<16;r+=4){a=MX3(a,C0[r],C0[r+1]);b=MX3(b,C0[r+2],C0[r+3]);a=MX3(a,C1[r],C1[r+1]);b=MX3(b,C1[r+2],C1[r+3]);} \
      float rm=__builtin_fmaxf(a,b); { auto rr=__builtin_amdgcn_permlane32_swap(__float_as_uint(rm),__float_as_uint(rm),false,false); rm=__builtin_fmaxf(__uint_as_float(rr[0]),__uint_as_float(rr[1])); } \
      resc=false; \
      if(__builtin_expect(__any(rm>(float)THRL),0)){ const float dl=__builtin_fmaxf(rm,0.f); mhat+=dl; \
        _Pragma("unroll") for(int r=0;r<16;++r){C0[r]-=dl;C1[r]-=dl;} \
        _Pragma("unroll") for(int r=0;r<16;++r)negm[r]=-mhat; asm volatile("":"+v"(negm)); \
        const float f=__builtin_amdgcn_exp2f(-dl); l_reg*=f; if(hi==0)wsf[r32]=f; resc=true; } } \
    SBAR(); \
    GAPB(o[0]=__builtin_amdgcn_mfma_f32_32x32x16_bf16(PAF(0),VFR(0),o[0],0,0,0), C0,0); \
    GAPB(o[1]=__builtin_amdgcn_mfma_f32_32x32x16_bf16(PAF(0),VFR(4),o[1],0,0,0), C0,4); \
    KRD(GL,0); GAPB(o[0]=__builtin_amdgcn_mfma_f32_32x32x16_bf16(PAF(1),VFR(1),o[0],0,0,0), C0,8); \
    KRD(GL,1); GAPB(o[1]=__builtin_amdgcn_mfma_f32_32x32x16_bf16(PAF(1),VFR(5),o[1],0,0,0), C0,12); \
    KRD(GL,2); GAPB(o[0]=__builtin_amdgcn_mfma_f32_32x32x16_bf16(PAF(2),VFR(2),o[0],0,0,0), C1,0); \
    KRD(GL,3); GAPB(o[1]=__builtin_amdgcn_mfma_f32_32x32x16_bf16(PAF(2),VFR(6),o[1],0,0,0), C1,4); \
    GAPB(o[0]=__builtin_amdgcn_mfma_f32_32x32x16_bf16(PAF(3),VFR(3),o[0],0,0,0), C1,8); \
    GAPB(o[1]=__builtin_amdgcn_mfma_f32_32x32x16_bf16(PAF(3),VFR(7),o[1],0,0,0), C1,12); \
    }while(0)
  int t=1;
  #undef CMASK
  #define CMASK(P0,P1,t) do{}while(0)
  for(;t+5<NT;t+=2){
    STEP(pB0,pB1,pA0,pA1,t,true,true,true);     WAIT_BAR(2); RESC(); ROT();
    STEP(pA0,pA1,pB0,pB1,t+1,true,true,true);   WAIT_BAR(2); RESC(); ROT();
  }
  #undef CMASK
  #define CMASK(P0,P1,t) do{}while(0)
  #define ENDW(tt) do{ if((tt)+3<NT){WAIT_BAR(2);} else if((tt)+2<NT){WAIT_BAR(1);} else {WAIT_BAR(0);} }while(0)
  for(;t+1<NT;t+=2){
    STEP(pB0,pB1,pA0,pA1,t,(t+3<NT),(t+1<NT),(t+1<NT));       ENDW(t);   RESC(); ROT();
    STEP(pA0,pA1,pB0,pB1,t+1,(t+4<NT),(t+2<NT),(t+2<NT));     ENDW(t+1); RESC(); ROT();
  }
  STEP(pB0,pB1,pA0,pA1,NT-1,false,false,false); RESC();
  { float sacc=pB0[0]+pB0[1]; _Pragma("unroll") for(int r=2;r<16;++r)sacc+=pB0[r]; _Pragma("unroll") for(int r=0;r<16;++r)sacc+=pB1[r]; l_reg+=sacc;
    pw0=(u32x4){PKW(pB0,0),PKW(pB0,2),PKW(pB0,4),PKW(pB0,6)};pw1=(u32x4){PKW(pB0,8),PKW(pB0,10),PKW(pB0,12),PKW(pB0,14)};pw2=(u32x4){PKW(pB1,0),PKW(pB1,2),PKW(pB1,4),PKW(pB1,6)};pw3=(u32x4){PKW(pB1,8),PKW(pB1,10),PKW(pB1,12),PKW(pB1,14)};
    SBAR(); pv(o,vb0+sl_cur,PAF(0),PAF(1),PAF(2),PAF(3)); }
  #undef PKW
  #undef PAF
  #undef VFR
  #undef PIN
  #undef MX3
  #undef GAPA
  #undef GAPB
  #undef EX
  #undef VRD
  #undef KRD
  #undef STEP
  #undef ENDW
  {auto rr=__builtin_amdgcn_permlane32_swap(__float_as_uint(l_reg),__float_as_uint(l_reg),false,false);l_reg=__uint_as_float(rr[0])+__uint_as_float(rr[1]);}
  if(hi==0)wsf[32+r32]=l_reg;asm volatile("s_waitcnt lgkmcnt(0)":::"memory");
  float rli[16];
  #pragma unroll
  for(int r=0;r<16;++r)rli[r]=__builtin_amdgcn_rcpf(wsf[32+crow(r,hi)]);
  bf16*Ow=Oblk+(long)wid*QBLK*po;
  { bf16*stg=(bf16*)(shm+LDS_OST)+wid*2048;
    #pragma unroll
    for(int r=0;r<16;++r){const int orow=crow(r,hi);
      #pragma unroll
      for(int d0=0;d0<2;++d0)stg[orow*64+d0*32+r32]=__float2bfloat16(o[d0][r]*rli[r]);}
    asm volatile("s_waitcnt lgkmcnt(0)":::"memory");
    #pragma unroll
    for(int i=0;i<4;++i){const int row=i*8+(lane>>3),ch=lane&7; const u32x4 v=*(const u32x4*)(stg+row*64+ch*8); ATTN_STORE16(Ow+(long)row*po+ch*8,v);} }
  asm volatile("s_waitcnt lgkmcnt(0)\n\ts_barrier":::"memory");
  #undef DMA_K
  #undef DMA_V
  #undef CMASK
  #undef START
  #undef RESC
  #undef ROT
}
constexpr int LDS_WS8=LDS_V+3*2*SLOTB, LDS_OST8=LDS_WS8+NW*64*4, LDS_BYTES8=LDS_OST8+NW*8192;
typedef float f32x4_t __attribute__((ext_vector_type(4)));
template<int THRL,int MODE> __device__ __forceinline__ void attn_unit128(const bf16*Qblk,const bf16*__restrict__ Kh,const bf16*__restrict__ Vh,bf16*Oblk,const int NT,char*shm,const bf16*O1blk,bf16*AOblk,const float lam,const float*sln,const float omli){
  int tid_=threadIdx.x; asm volatile("":"+v"(tid_));
  const int tid=tid_,lane=tid&63,r32=lane&31,hi=lane>>5; const int wid=__builtin_amdgcn_readfirstlane(tid>>6);
  const bf16*Qw=Qblk+(long)wid*QBLK*PQ;
  const unsigned lds0=(unsigned)(uintptr_t)shm;
  float*wsf=(float*)(shm+LDS_WS8)+wid*64;
  const unsigned koff=(unsigned)(lane*PQ+wid*8)*2u;
  const unsigned voff=(unsigned)((16*(wid&3)+(lane>>2))*PQ+(wid>>2)*32+(lane&3)*8)*2u;
  const unsigned kdst=lds0+LDS_K+wid*1024, vdst=lds0+LDS_V+wid*1024;
  #define DMA_K(t,slot) glds16((const char*)Kh+(size_t)(t)*(KVBLK*PQ*2)+koff,(unsigned)__builtin_amdgcn_readfirstlane(kdst+(slot)))
  #define DMA_V(t,slot) do{ glds16((const char*)Vh+(size_t)(t)*(KVBLK*PQ*2)+voff,(unsigned)__builtin_amdgcn_readfirstlane(vdst+2*(slot))); glds16((const char*)Vh+(size_t)(t)*(KVBLK*PQ*2)+128+voff,(unsigned)__builtin_amdgcn_readfirstlane(vdst+2*(slot)+8192)); }while(0)
  const char*Kbase=shm+LDS_K; bf16x8 kf[8];
  const lds_cptr shm3=(lds_cptr)shm; const lds_cptr kp0=shm3+LDS_K+hi*1024+r32*16; const lds_cptr vp0=shm3+LDS_V+((lane>>4)&1)*32+(lane&3)*8+(4*hi+((lane&15)>>2))*64;
  DMA_K(0,0);DMA_V(0,0);DMA_K(1,SLOTB);
  bf16x8 qr[4];
  #pragma unroll
  for(int d0=0;d0<4;++d0)qr[d0]=*reinterpret_cast<const bf16x8*>(&Qw[(long)r32*PQ+d0*16+hi*8]);
  float mhat=0.f,l_reg=0.f;f32x16 o[4];o[0]=f32x16{};o[1]=f32x16{};o[2]=f32x16{};o[3]=f32x16{};f32x16 negm=f32x16{};asm volatile("":"+v"(negm));
  #define CMASK(P0,P1,t) do{}while(0)
  bool resc=false;
  #define START(P0,P1) do{ const float rm=rowmax(P0,P1); resc=false; \
    { const float dl=rm; mhat=fadd_s(mhat,dl); \
      _Pragma("unroll") for(int r=0;r<16;++r){P0[r]=fsub_s(P0[r],dl);P1[r]=fsub_s(P1[r],dl);} \
      _Pragma("unroll") for(int r=0;r<16;++r)negm[r]=-mhat; asm volatile("":"+v"(negm)); } \
    _Pragma("unroll") for(int r=0;r<16;++r)P0[r]=__builtin_amdgcn_exp2f(P0[r]); }while(0)
  #define RESC() do{ if(resc){ asm volatile("s_waitcnt lgkmcnt(0)":::"memory"); \
      _Pragma("unroll") for(int d_=0;d_<4;++d_) _Pragma("unroll") for(int r=0;r<16;++r)o[d_][r]*=wsf[crow(r,hi)]; } }while(0)
  f32x16 pA0,pA1,pB0,pB1;
  int sl_prev=0,sl_cur=0,sl_next=SLOTB;
  #define ROT() do{sl_prev=sl_cur;sl_cur=sl_next;sl_next=(sl_next==(NSLOT-1)*SLOTB)?0:sl_next+SLOTB;}while(0)
  DMA_K(2,2*SLOTB);
  WAIT_BAR(4);
  qkt(pA0,pA1,Kbase,qr,negm,r32,hi);asm volatile("s_nop 15\n\ts_nop 7":"+v"(pA0),"+v"(pA1));CMASK(pA0,pA1,0);
  START(pA0,pA1);
  _Pragma("unroll") for(int r=0;r<16;++r)pA1[r]=__builtin_amdgcn_exp2f(pA1[r]);
  WAIT_BAR(0);
  DMA_K(3,0);DMA_V(1,SLOTB);
  ROT();
  kload8(kf,kp0+sl_cur);
  WAIT_BAR(3);
  s16x4 vlo[8],vhi[8]; u32x4 pw0,pw1,pw2,pw3;
  #define PKW(P,B) cvtpk_s(P[B],P[B+1])
  #define PAF(k) __builtin_bit_cast(bf16x8,pw##k)
  #define VFR(i) (bf16x8){vlo[i][0],vlo[i][1],vlo[i][2],vlo[i][3],vhi[i][0],vhi[i][1],vhi[i][2],vhi[i][3]}
  #define PIN(x) asm volatile("":"+v"(x))
  #define MX3(a,b,c) __builtin_fmaxf(__builtin_fmaxf((a),(b)),(c))
  #define GAPA(MF,A0,A1,A2,A3,W0,W1,PW) do{ MF; sacc+=A0; sacc+=A1; sacc+=A2; sacc+=A3; PIN(sacc); W0; W1; PIN(PW); SBAR(); }while(0)
  #define EX(v) __builtin_amdgcn_exp2f(v)
  #define GAPB(MF,X,B,RL) do{ MF; X[B]=EX(X[B]); X[B+1]=EX(X[B+1]); RL; PIN(X); SBAR(); }while(0)
  #define VRD(i) do{ vlo[i]=vtr(vp_+(((i)>>2)*4096+((i)&3)*1024)); vhi[i]=vtr(vp_+(((i)>>2)*4096+((i)&3)*1024+512)); }while(0)
  #define VRDH(i) do{ vlo[i]=vtr(vp_+((((i)>>2)+2)*4096+((i)&3)*1024)); vhi[i]=vtr(vp_+((((i)>>2)+2)*4096+((i)&3)*1024+512)); }while(0)
  #define NORL do{}while(0)
  #define KRD(G,j) do{ if(G){ kload2(kf,kp0+sl_next,j); SBAR(); } }while(0)
  #define STEP(C0,C1,P0,P1,t,GK,GV,GL) do{ SBAR(); \
    const lds_cptr vp_=vp0+2*sl_prev; \
    float sacc=(P0[0]+P0[1]); \
    GAPA(C0=__builtin_amdgcn_mfma_f32_32x32x16_bf16(kf[0],qr[0],negm,0,0,0), P0[2],P0[3],P0[4],P0[5],     pw0[0]=PKW(P0,0), pw0[1]=PKW(P0,2), pw0); \
    GAPA(C1=__builtin_amdgcn_mfma_f32_32x32x16_bf16(kf[1],qr[0],negm,0,0,0), P0[6],P0[7],P0[8],P0[9],     pw0[2]=PKW(P0,4), pw0[3]=PKW(P0,6), pw0); \
    GAPA(C0=__builtin_amdgcn_mfma_f32_32x32x16_bf16(kf[2],qr[1],C0,0,0,0),   P0[10],P0[11],P0[12],P0[13], pw1[0]=PKW(P0,8), pw1[1]=PKW(P0,10), pw1); \
    GAPA(C1=__builtin_amdgcn_mfma_f32_32x32x16_bf16(kf[3],qr[1],C1,0,0,0),   P0[14],P0[15],P1[0],P1[1],   pw1[2]=PKW(P0,12),pw1[3]=PKW(P0,14), pw1); \
    GAPA(C0=__builtin_amdgcn_mfma_f32_32x32x16_bf16(kf[4],qr[2],C0,0,0,0),   P1[2],P1[3],P1[4],P1[5],     pw2[0]=PKW(P1,0), pw2[1]=PKW(P1,2), pw2); \
    GAPA(C1=__builtin_amdgcn_mfma_f32_32x32x16_bf16(kf[5],qr[2],C1,0,0,0),   P1[6],P1[7],P1[8],P1[9],     pw2[2]=PKW(P1,4), pw2[3]=PKW(P1,6), pw2); \
    GAPA(C0=__builtin_amdgcn_mfma_f32_32x32x16_bf16(kf[6],qr[3],C0,0,0,0),   P1[10],P1[11],P1[12],P1[13], pw3[0]=PKW(P1,8), pw3[1]=PKW(P1,10), pw3); \
    GAPA(C1=__builtin_amdgcn_mfma_f32_32x32x16_bf16(kf[7],qr[3],C1,0,0,0),   P1[14],P1[15],0.f,0.f,       pw3[2]=PKW(P1,12),pw3[3]=PKW(P1,14), pw3); \
    l_reg+=sacc; \
    VRD(0);VRD(4);VRD(1);VRD(5); SBAR(); VRD(2);VRD(6);VRD(3);VRD(7); SBAR();     \
    if(GK){DMA_K((t)+3,sl_cur);} if(GV){DMA_V((t)+1,sl_next);} \
    { float a=MX3(C0[0],C0[1],C1[0]),b=MX3(C0[2],C0[3],C1[1]); a=MX3(a,C1[2],C1[3]); \
      _Pragma("unroll") for(int r=4;r<16;r+=4){a=MX3(a,C0[r],C0[r+1]);b=MX3(b,C0[r+2],C0[r+3]);a=MX3(a,C1[r],C1[r+1]);b=MX3(b,C1[r+2],C1[r+3]);} \
      float rm=__builtin_fmaxf(a,b); { auto rr=__builtin_amdgcn_permlane32_swap(__float_as_uint(rm),__float_as_uint(rm),false,false); rm=__builtin_fmaxf(__uint_as_float(rr[0]),__uint_as_float(rr[1])); } \
      resc=false; \
      if(__builtin_expect(__any(rm>(float)THRL),0)){ const float dl=__builtin_fmaxf(rm,0.f); mhat+=dl; \
        _Pragma("unroll") for(int r=0;r<16;++r){C0[r]-=dl;C1[r]-=dl;} \
        _Pragma("unroll") for(int r=0;r<16;++r)negm[r]=-mhat; asm volatile("":"+v"(negm)); \
        const float f=__builtin_amdgcn_exp2f(-dl); l_reg*=f; if(hi==0)wsf[r32]=f; resc=true; } } \
    SBAR(); \
    GAPB(o[0]=__builtin_amdgcn_mfma_f32_32x32x16_bf16(PAF(0),VFR(0),o[0],0,0,0), C0,0,  VRDH(0)); \
    GAPB(o[1]=__builtin_amdgcn_mfma_f32_32x32x16_bf16(PAF(0),VFR(4),o[1],0,0,0), C0,2,  VRDH(4)); \
    GAPB(o[0]=__builtin_amdgcn_mfma_f32_32x32x16_bf16(PAF(1),VFR(1),o[0],0,0,0), C0,4,  VRDH(1)); \
    GAPB(o[1]=__builtin_amdgcn_mfma_f32_32x32x16_bf16(PAF(1),VFR(5),o[1],0,0,0), C0,6,  VRDH(5)); \
    GAPB(o[0]=__builtin_amdgcn_mfma_f32_32x32x16_bf16(PAF(2),VFR(2),o[0],0,0,0), C0,8,  VRDH(2)); \
    GAPB(o[1]=__builtin_amdgcn_mfma_f32_32x32x16_bf16(PAF(2),VFR(6),o[1],0,0,0), C0,10, VRDH(6)); \
    GAPB(o[0]=__builtin_amdgcn_mfma_f32_32x32x16_bf16(PAF(3),VFR(3),o[0],0,0,0), C0,12, VRDH(3)); \
    GAPB(o[1]=__builtin_amdgcn_mfma_f32_32x32x16_bf16(PAF(3),VFR(7),o[1],0,0,0), C0,14, VRDH(7)); \
    GAPB(o[2]=__builtin_amdgcn_mfma_f32_32x32x16_bf16(PAF(0),VFR(0),o[2],0,0,0), C1,0,  NORL); \
    GAPB(o[3]=__builtin_amdgcn_mfma_f32_32x32x16_bf16(PAF(0),VFR(4),o[3],0,0,0), C1,2,  NORL); \
    KRD(GL,0); GAPB(o[2]=__builtin_amdgcn_mfma_f32_32x32x16_bf16(PAF(1),VFR(1),o[2],0,0,0), C1,4,  NORL); \
    KRD(GL,1); GAPB(o[3]=__builtin_amdgcn_mfma_f32_32x32x16_bf16(PAF(1),VFR(5),o[3],0,0,0), C1,6,  NORL); \
    KRD(GL,2); GAPB(o[2]=__builtin_amdgcn_mfma_f32_32x32x16_bf16(PAF(2),VFR(2),o[2],0,0,0), C1,8,  NORL); \
    KRD(GL,3); GAPB(o[3]=__builtin_amdgcn_mfma_f32_32x32x16_bf16(PAF(2),VFR(6),o[3],0,0,0), C1,10, NORL); \
    GAPB(o[2]=__builtin_amdgcn_mfma_f32_32x32x16_bf16(PAF(3),VFR(3),o[2],0,0,0), C1,12, NORL); \
    GAPB(o[3]=__builtin_amdgcn_mfma_f32_32x32x16_bf16(PAF(3),VFR(7),o[3],0,0,0), C1,14, NORL); \
    }while(0)
  int t=1;
  #undef CMASK
  #define CMASK(P0,P1,t) do{}while(0)
  for(;t+5<NT;t+=2){
    STEP(pB0,pB1,pA0,pA1,t,true,true,true);     WAIT_BAR(3); RESC(); ROT();
    STEP(pA0,pA1,pB0,pB1,t+1,true,true,true);   WAIT_BAR(3); RESC(); ROT();
  }
  #undef CMASK
  #define CMASK(P0,P1,t) do{}while(0)
  #define ENDW(tt) do{ if((tt)+3<NT){WAIT_BAR(3);} else if((tt)+2<NT){WAIT_BAR(2);} else {WAIT_BAR(0);} }while(0)
  for(;t+1<NT;t+=2){
    STEP(pB0,pB1,pA0,pA1,t,(t+3<NT),(t+1<NT),(t+1<NT));       ENDW(t);   RESC(); ROT();
    STEP(pA0,pA1,pB0,pB1,t+1,(t+4<NT),(t+2<NT),(t+2<NT));     ENDW(t+1); RESC(); ROT();
  }
  STEP(pB0,pB1,pA0,pA1,NT-1,false,false,false); RESC();
  { float sacc=pB0[0]+pB0[1]; _Pragma("unroll") for(int r=2;r<16;++r)sacc+=pB0[r]; _Pragma("unroll") for(int r=0;r<16;++r)sacc+=pB1[r]; l_reg+=sacc;
    pw0=(u32x4){PKW(pB0,0),PKW(pB0,2),PKW(pB0,4),PKW(pB0,6)};pw1=(u32x4){PKW(pB0,8),PKW(pB0,10),PKW(pB0,12),PKW(pB0,14)};pw2=(u32x4){PKW(pB1,0),PKW(pB1,2),PKW(pB1,4),PKW(pB1,6)};pw3=(u32x4){PKW(pB1,8),PKW(pB1,10),PKW(pB1,12),PKW(pB1,14)};
    SBAR(); { const int vb0=(int)(unsigned)(size_t)vp0; pv(o,vb0+2*sl_cur,PAF(0),PAF(1),PAF(2),PAF(3)); pv(o+2,vb0+2*sl_cur+8192,PAF(0),PAF(1),PAF(2),PAF(3)); } }
  #undef PKW
  #undef PAF
  #undef VFR
  #undef PIN
  #undef MX3
  #undef GAPA
  #undef GAPB
  #undef EX
  #undef VRD
  #undef VRDH
  #undef NORL
  #undef KRD
  #undef STEP
  #undef ENDW
  {auto rr=__builtin_amdgcn_permlane32_swap(__float_as_uint(l_reg),__float_as_uint(l_reg),false,false);l_reg=__uint_as_float(rr[0])+__uint_as_float(rr[1]);}
  if(hi==0)wsf[32+r32]=l_reg;asm volatile("s_waitcnt lgkmcnt(0)":::"memory");
  float rli[16];
  #pragma unroll
  for(int r=0;r<16;++r)rli[r]=__builtin_amdgcn_rcpf(wsf[32+crow(r,hi)]);
  bf16*Ow=Oblk+(long)wid*QBLK*PO;
  if constexpr(MODE==0)
  { bf16*stg=(bf16*)(shm+LDS_OST8)+wid*2048;
    #pragma unroll
    for(int h2=0;h2<2;++h2){
      #pragma unroll
      for(int r=0;r<16;++r){const int orow=crow(r,hi);
        #pragma unroll
        for(int d0=0;d0<2;++d0)stg[orow*64+d0*32+r32]=__float2bfloat16(o[2*h2+d0][r]*rli[r]);}
      asm volatile("s_waitcnt lgkmcnt(0)":::"memory");
      #pragma unroll
      for(int i=0;i<4;++i){const int row=i*8+(lane>>3),ch=lane&7; const u32x4 v=*(const u32x4*)(stg+row*64+ch*8); ATTN_STORE16(Ow+(long)row*PO+h2*64+ch*8,v);}
      asm volatile("s_waitcnt lgkmcnt(0)":::"memory");
    } }
  else {
    bf16*stg=(bf16*)(shm+LDS_OST8)+wid*4096;
    #pragma unroll
    for(int r=0;r<16;++r){const int orow=crow(r,hi);
      #pragma unroll
      for(int d0=0;d0<4;++d0)stg[orow*128+d0*32+r32]=__float2bfloat16(o[d0][r]*rli[r]);}
    asm volatile("s_waitcnt lgkmcnt(0)":::"memory");
    const int row=lane>>1,hf=lane&1;
    const bf16*O1w=O1blk+((long)wid*QBLK+row)*PO+hf*64; bf16*AOw=AOblk+((long)wid*QBLK+row)*1024+hf*64;
    u32x4 a2[8],a1[8];
    #pragma unroll
    for(int i=0;i<8;++i){a2[i]=*(const u32x4*)(stg+row*128+hf*64+i*8); a1[i]=*(const u32x4*)(O1w+i*8);}
    float x[64]; float ss=0.f;
    #pragma unroll
    for(int i=0;i<8;++i){
      #pragma unroll
      for(int c=0;c<4;++c){const unsigned u1=a1[i][c],u2=a2[i][c];
        const float lo=__uint_as_float(u1<<16)-lam*__uint_as_float(u2<<16), hi2=__uint_as_float(u1&0xffff0000u)-lam*__uint_as_float(u2&0xffff0000u);
        x[i*8+2*c]=lo; x[i*8+2*c+1]=hi2; ss+=lo*lo+hi2*hi2;}}
    ss+=__shfl_xor(ss,1);
    const float rstd=1.f/sqrtf(ss*(1.f/128.f)+1e-6f)*omli;
    #pragma unroll
    for(int i=0;i<8;++i){ const f32x4_t s0=*(const f32x4_t*)(sln+hf*64+i*8), s1=*(const f32x4_t*)(sln+hf*64+i*8+4);
      u32x4 w; w[0]=cvtpk_s(x[i*8]*rstd*s0[0],x[i*8+1]*rstd*s0[1]); w[1]=cvtpk_s(x[i*8+2]*rstd*s0[2],x[i*8+3]*rstd*s0[3]);
      w[2]=cvtpk_s(x[i*8+4]*rstd*s1[0],x[i*8+5]*rstd*s1[1]); w[3]=cvtpk_s(x[i*8+6]*rstd*s1[2],x[i*8+7]*rstd*s1[3]);
      ATTN_STORE16(AOw+i*8,w);}
    asm volatile("s_waitcnt lgkmcnt(0)":::"memory");
  }
  asm volatile("s_waitcnt lgkmcnt(0)\n\ts_barrier":::"memory");
  #undef DMA_K
  #undef DMA_V
  #undef CMASK
  #undef START
  #undef RESC
  #undef ROT
}
constexpr int ATTN_LDS_BYTES=LDS_BYTES;
#undef SBAR
#undef WAIT_BAR
}
#define GAS __attribute__((address_space(1)))
#define LAS __attribute__((address_space(3)))
typedef unsigned short bfu;
typedef unsigned v4u __attribute__((ext_vector_type(4)));
typedef unsigned v2u __attribute__((ext_vector_type(2)));
typedef float f32x4 __attribute__((ext_vector_type(4)));
typedef float f32x16 __attribute__((ext_vector_type(16)));
typedef short bf16x8 __attribute__((ext_vector_type(8)));
#define LDS_WAIT() asm volatile("s_waitcnt lgkmcnt(0)" ::: "memory")
#define DI __device__ __forceinline__

#define XB_TMO      128
#define XB_XCNT(j)  (256  + 64 * (j))
#define XB_XSUB(j)  (1280 + 64 * (j))
#define XB_XGEN(j)  (2304 + 64 * (j))
#define XB_TOP      3328
#define XB_TOPGEN   3392
#define XCD_BAR_WORDS 3456
#define XB_SPIN_CAP (1u << 18)

__device__ __forceinline__ unsigned xb_ld(unsigned* p)              { return __hip_atomic_load(p, __ATOMIC_RELAXED, __HIP_MEMORY_SCOPE_AGENT); }
__device__ __forceinline__ unsigned xb_add(unsigned* p, unsigned v) { return __hip_atomic_fetch_add(p, v, __ATOMIC_RELAXED, __HIP_MEMORY_SCOPE_AGENT); }
__device__ __forceinline__ unsigned xb_xcc_id() { return (unsigned)__builtin_amdgcn_s_getreg((3 << 11) | 20) & 0xFu; }
#define XB_SPIN(cond, bar) do { unsigned _sp = 0; while (cond) { __builtin_amdgcn_s_sleep(1); \
    if ((++_sp & 255u) == 0u) { if (xb_ld(&(bar)[XB_TMO])) break; if (_sp > XB_SPIN_CAP) { atomicAdd(&(bar)[XB_TMO], 1u); break; } } } } while (0)

struct XcdBarrier {
    unsigned* bar; unsigned x;
    volatile LAS unsigned* st;
};

__device__ __forceinline__ XcdBarrier xcd_barrier_post(unsigned* bar, volatile LAS unsigned* st) {
    XcdBarrier b; b.bar = bar; b.x = xb_xcc_id(); b.st = st;
    if (threadIdx.x == 0) (void)xb_add(&bar[XB_XCNT(b.x)], 1u);
    return b;
}
__device__ __forceinline__ void xcd_barrier_complete(unsigned* bar, unsigned x, unsigned& nloc, unsigned& nx) {
    const unsigned G = gridDim.x * gridDim.y * gridDim.z;
    unsigned sum, cnt, mine, sp = 0u;
    for (;;) {
        sum = 0u; cnt = 0u; mine = 0u;
#pragma unroll
        for (unsigned j = 0; j < 16; ++j) { const unsigned c = xb_ld(&bar[XB_XCNT(j)]); sum += c; cnt += (c > 0u) ? 1u : 0u; mine = (j == x) ? c : mine; }
        if (sum == G) break;
        __builtin_amdgcn_s_sleep(1);
        if ((++sp & 255u) == 0u) { if (xb_ld(&bar[XB_TMO])) break; if (sp > XB_SPIN_CAP) { atomicAdd(&bar[XB_TMO], 1u); break; } }
    }
    nloc = mine > 0u ? mine : 1u; nx = cnt > 0u ? cnt : 1u;
}

__device__ __forceinline__ void xcd_barrier(const XcdBarrier& b) {
    asm volatile("s_waitcnt vmcnt(0)" ::: "memory");
    __syncthreads();
    if (threadIdx.x == 0) {
        unsigned* bar = b.bar;
        __builtin_amdgcn_s_waitcnt(0);
        unsigned nloc = b.st[0], nx = b.st[1];
        if (nloc == 0u) { xcd_barrier_complete(bar, b.x, nloc, nx); b.st[0] = nloc; b.st[1] = nx; }
        const unsigned old = xb_add(&bar[XB_XSUB(b.x)], 1u);
        const unsigned gen = old / nloc;
        if (old + 1u == (gen + 1u) * nloc) {
            __builtin_amdgcn_fence(__ATOMIC_RELEASE, "agent");
            asm volatile("s_waitcnt vmcnt(0)" ::: "memory");
            const unsigned og = xb_add(&bar[XB_TOP], 1u);
            const unsigned tg = og / nx;
            if (og + 1u == (tg + 1u) * nx) xb_add(&bar[XB_TOPGEN], 1u);
            else XB_SPIN(xb_ld(&bar[XB_TOPGEN]) == tg, bar);
            __builtin_amdgcn_fence(__ATOMIC_ACQUIRE, "agent");
            xb_add(&bar[XB_XGEN(b.x)], 1u);
            asm volatile("s_waitcnt vmcnt(0)" ::: "memory");
        } else {
            XB_SPIN(xb_ld(&bar[XB_XGEN(b.x)]) == gen, bar);
            __builtin_amdgcn_fence(__ATOMIC_ACQUIRE, "agent");
            asm volatile("s_waitcnt vmcnt(0)" ::: "memory");
        }
    }
    __syncthreads();
}


constexpr int DM = 1024, NBATCH = 2, SEQ = 16384, CTXL = 256, SEGR = SEQ + CTXL, MROWS = NBATCH * SEGR;
constexpr int FFN = 2816, NQKV = 2304, NAO = 1536, NMOD = 6 * DM;
constexpr float EPS = 1e-6f;
constexpr int NWAVES = 8, NTHR = 512;
constexpr int LDS_BYTES = 147456;
constexpr size_t MiB = 1u << 20;
constexpr size_t WS_MODS = 0;
constexpr size_t WS_BAR = 512 * 1024, BAR_BYTES = 16384;
constexpr size_t WS_CTXX = 1 * MiB;
constexpr size_t WS_RSTD = 29 * MiB;
constexpr size_t WS_WMIXA = 4 * MiB, WS_WMIXB = 4 * MiB + 4608 * 1024, WS_WMIXS = 4 * MiB + 6656 * 1024;
constexpr size_t WS_WUP = 12 * MiB, WS_WDN = 23 * MiB;
constexpr size_t WS_H = 32 * MiB;
constexpr size_t WS_BIG = 98 * MiB;
constexpr size_t WS_QKV = WS_BIG, WS_AORAW = WS_BIG + 147 * MiB, WS_AO = WS_BIG + 245 * MiB;
constexpr size_t WS_UV = WS_BIG, WS_S = WS_BIG + 131 * MiB;
constexpr size_t WS_ZB = WS_BIG, WS_ACT = WS_BIG + 179 * MiB;
constexpr size_t WS_END = 456 * MiB;

DI unsigned f2bf(float f) { unsigned u = __builtin_bit_cast(unsigned, f); return (u + 0x7fffu + ((u >> 16) & 1u)) >> 16; }
typedef float f32x2_h __attribute__((ext_vector_type(2))); typedef __bf16 bf16x2_h __attribute__((ext_vector_type(2)));
DI unsigned pk2(float lo, float hi) { const f32x2_h v = {lo, hi}; return __builtin_bit_cast(unsigned, __builtin_convertvector(v, bf16x2_h)); }
DI float bflo(unsigned u) { return __builtin_bit_cast(float, u << 16); }
DI float bfhi(unsigned u) { return __builtin_bit_cast(float, u & 0xffff0000u); }
DI float wave_sum(float v) {
#pragma unroll
    for (int o = 1; o < 64; o <<= 1) v += __shfl_xor(v, o);
    return v;
}
DI float half_sum(float v) {
#pragma unroll
    for (int o = 1; o < 32; o <<= 1) v += __shfl_xor(v, o);
    return v;
}
DI float silu_f(float x) { return x * __builtin_amdgcn_rcpf(1.f + __builtin_amdgcn_exp2f(x * -1.4426950408889634f)); }
DI int opaque_tid() { int t = threadIdx.x; asm volatile("" : "+v"(t)); return t; }
#define PHASE_IDS() const int tid = opaque_tid(), lane = tid & 63, wave = __builtin_amdgcn_readfirstlane(tid >> 6), gw = bx * NWAVES + wave, ngw = G * NWAVES; (void)lane; (void)gw; (void)ngw; (void)wave

struct EpiResid {
    static constexpr bool PERM = false, AFTER_DRAIN = false;
    const float* slat; const float* sctx; float* xlat; float* xctx; const float* gate;
    DI void operator()(const pg8::f32x4 (&acc)[2][2][4][2], const pg8::Unit& u, int wr, int wc, int fr, int fq) const {
        const int b = u.pm / 65, pp = u.pm % 65;
        const size_t boff = (pp == 0) ? (size_t)(b * CTXL) * DM : ((size_t)b * SEQ + (size_t)(pp - 1) * 256) * DM;
        float* base = ((pp == 0) ? xctx : xlat) + boff; const float* sbase = ((pp == 0) ? sctx : slat) + boff;
        const float* gt = gate + ((pp == 0) ? 2 : b) * NMOD;
        const int row0 = wr * 64 + fr, col0 = u.pn * 256 + wc * 32 + 4 * fq;
        pg8::f32x4 gv[2][2];
#pragma unroll
        for (int bj = 0; bj < 2; ++bj)
#pragma unroll
            for (int n = 0; n < 2; ++n) gv[bj][n] = *(const pg8::f32x4*)(gt + col0 + bj * 128 + n * 16);
#pragma unroll
        for (int ai = 0; ai < 2; ++ai) {
            pg8::f32x4 xv[4][2][2];
#pragma unroll
            for (int m = 0; m < 4; ++m) { const float* srow = sbase + (size_t)(row0 + ai * 128 + m * 16) * DM + col0;
#pragma unroll
                for (int bj = 0; bj < 2; ++bj)
#pragma unroll
                    for (int n = 0; n < 2; ++n) xv[m][bj][n] = *(const pg8::f32x4*)(srow + bj * 128 + n * 16); }
#pragma unroll
            for (int m = 0; m < 4; ++m) { float* rowp = base + (size_t)(row0 + ai * 128 + m * 16) * DM + col0;
#pragma unroll
                for (int bj = 0; bj < 2; ++bj)
#pragma unroll
                    for (int n = 0; n < 2; ++n) *(pg8::f32x4*)(rowp + bj * 128 + n * 16) = xv[m][bj][n] + gv[bj][n] * acc[ai][bj][m][n]; }
        }
    }
};
struct EpiGeluV {
    static constexpr bool PERM = true, AFTER_DRAIN = false;
    bfu* O; float* part;
    DI void operator()(const pg8::f32x4 (&acc)[2][2][4][2], const pg8::Unit& u, int wr, int wc, int fr, int fq) const {
        const int row0 = u.pm * 256 + wr * 64 + fr, col0 = u.pn * 256 + wc * 32 + 8 * fq;
        const bool isv = u.pn >= 4;
#pragma unroll
        for (int ai = 0; ai < 2; ++ai)
#pragma unroll
            for (int m = 0; m < 4; ++m) { const int row = row0 + ai * 128 + m * 16; bfu* rowp = O + (size_t)row * 2048 + col0; float ss = 0.f;
#pragma unroll
                for (int bj = 0; bj < 2; ++bj) { const pg8::f32x4 v0 = acc[ai][bj][m][0], v1 = acc[ai][bj][m][1];
                    const pg8::f32x2 a = pg8::gelu_pk((pg8::f32x2){v0[0], v0[1]}), b = pg8::gelu_pk((pg8::f32x2){v0[2], v0[3]}), c = pg8::gelu_pk((pg8::f32x2){v1[0], v1[1]}), d = pg8::gelu_pk((pg8::f32x2){v1[2], v1[3]});
                    ss += (a.x * a.x + a.y * a.y) + (b.x * b.x + b.y * b.y) + (c.x * c.x + c.y * c.y) + (d.x * d.x + d.y * d.y);
                    pg8::u32x4 w; w.x = pg8::cvt_pk_bf16(a.x, a.y); w.y = pg8::cvt_pk_bf16(b.x, b.y); w.z = pg8::cvt_pk_bf16(c.x, c.y); w.w = pg8::cvt_pk_bf16(d.x, d.y);
                    *(pg8::u32x4*)(rowp + bj * 128) = w; }
                if (isv) { ss += __shfl_xor(ss, 16); ss += __shfl_xor(ss, 32); if (fq == 0) part[(size_t)row * 16 + (u.pn - 4) * 4 + wc] = ss; }
            }
    }
};
DI float dpp_prev(float x) { return __builtin_bit_cast(float, __builtin_amdgcn_update_dpp(0, __builtin_bit_cast(int, x), 0x111, 0xf, 0xf, true)); }
DI float dpp_next(float x) { return __builtin_bit_cast(float, __builtin_amdgcn_update_dpp(0, __builtin_bit_cast(int, x), 0x101, 0xf, 0xf, true)); }
struct EpiConv {
    static constexpr bool PERM = false, AFTER_DRAIN = false;
    bfu* ACT; bfu* ZB; const float* cw; const float* cb;
    DI void operator()(const pg8::f32x4 (&acc)[2][2][4][2], const pg8::Unit& u, int wr, int wc, int fr, int fq) const {
        const int row0 = u.pm * 256 + wr * 64 + fr;
        const bool edge = (fr < 2) || (fr >= 14); const int eidx = (fr < 2) ? fr : fr - 12;
#pragma unroll
        for (int n = 0; n < 2; ++n) {
            const int jt = wc * 32 + n * 16 + 4 * fq, j = u.pn * 128 + jt;
            const pg8::f32x4 g0 = *(const pg8::f32x4*)(cw + j), g1 = *(const pg8::f32x4*)(cw + 2 * FFN + j), g2 = *(const pg8::f32x4*)(cw + 4 * FFN + j), gb = *(const pg8::f32x4*)(cb + j);
            const pg8::f32x4 u0 = *(const pg8::f32x4*)(cw + FFN + j), u1 = *(const pg8::f32x4*)(cw + 3 * FFN + j), u2 = *(const pg8::f32x4*)(cw + 5 * FFN + j), ub = *(const pg8::f32x4*)(cb + FFN + j);
#pragma unroll
            for (int ai = 0; ai < 2; ++ai)
#pragma unroll
                for (int m = 0; m < 4; ++m) {
                    const int row = row0 + ai * 128 + m * 16;
                    const pg8::f32x4 zg = acc[ai][0][m][n], zu = acc[ai][1][m][n];
                    pg8::f32x4 pg, ng, pu, nu;
#pragma unroll
                    for (int i = 0; i < 4; ++i) { pg[i] = dpp_prev(zg[i]); ng[i] = dpp_next(zg[i]); pu[i] = dpp_prev(zu[i]); nu[i] = dpp_next(zu[i]); }
                    const pg8::f32x4 cg = g0 * pg + g1 * zg + g2 * ng + gb, cu = u0 * pu + u1 * zu + u2 * nu + ub;
                    v2u o; o.x = pk2(silu_f(cg[0]) * cu[0], silu_f(cg[1]) * cu[1]); o.y = pk2(silu_f(cg[2]) * cu[2], silu_f(cg[3]) * cu[3]);
                    *(v2u*)(ACT + (size_t)row * FFN + j) = o;
                    if (edge) { bfu* zb = ZB + ((size_t)(row >> 4) * 4 + eidx) * (2 * FFN) + u.pn * 256 + jt;
                        v2u a; a.x = pk2(zg[0], zg[1]); a.y = pk2(zg[2], zg[3]); *(v2u*)zb = a;
                        v2u b; b.x = pk2(zu[0], zu[1]); b.y = pk2(zu[2], zu[3]); *(v2u*)(zb + 128) = b; }
                }
        }
    }
};
struct RowSched {
    pg8::StaticOrder so; int skip;
    DI void init(int N, int G, int c, int skip_ctx, int wgm = pg8::WGM) { so.init(skip_ctx ? NBATCH * SEQ : MROWS, N, G, c, wgm); skip = skip_ctx; }
    DI bool next(int i, pg8::Unit& u) const { if (!so.next(i, u)) return false; if (skip) u.pm = (u.pm >> 6) * 65 + 1 + (u.pm & 63); return true; }
    DI void a_ready(const pg8::Unit&) const {}
    DI void done(const pg8::Unit&) const {}
};

template <int NB  > DI void p_ctx_resid(const bfu* A, int K, const bfu* Wt, const float* xsrc, float* xdst, const float* gate, LAS unsigned char* lds, int bx, int G) {
    PHASE_IDS();
    const int r32 = lane & 31, hi = lane >> 5;
    LAS float* part = (LAS float*)lds;
    const int spw = K / 128;
    for (int blk = bx; blk < 256; blk += G) {
        const int rb = blk >> 4, cb = blk & 15, cr0 = rb * 32, c0 = cb * 64;
        const int cr = cr0 + r32, grow = (cr >> 8) * SEGR + (cr & 255);
        const bfu* ap = A + (size_t)grow * K + (size_t)wave * spw * 16 + 8 * hi;
        const bfu* bp0 = Wt + (size_t)(c0 + r32) * K + (size_t)wave * spw * 16 + 8 * hi;
        const bfu* bp1 = bp0 + (size_t)32 * K;
        f32x16 acc0 = f32x16{}, acc1 = f32x16{};
#pragma unroll 1
        for (int s0 = 0; s0 < spw; s0 += NB) {
            bf16x8 af[NB], b0[NB], b1[NB];
#pragma unroll
            for (int q = 0; q < NB; ++q) { af[q] = *(const bf16x8*)(ap + 16 * (s0 + q)); b0[q] = *(const bf16x8*)(bp0 + 16 * (s0 + q)); b1[q] = *(const bf16x8*)(bp1 + 16 * (s0 + q)); }
#pragma unroll
            for (int q = 0; q < NB; ++q) { acc0 = __builtin_amdgcn_mfma_f32_32x32x16_bf16(af[q], b0[q], acc0, 0, 0, 0); acc1 = __builtin_amdgcn_mfma_f32_32x32x16_bf16(af[q], b1[q], acc1, 0, 0, 0); }
        }
        LAS float* pw = part + ((wave * 2) * 64 + lane) * 16;
#pragma unroll
        for (int v = 0; v < 16; ++v) { pw[v] = acc0[v]; pw[64 * 16 + v] = acc1[v]; }
        __syncthreads();
        { const int e = tid * 4, j = e >> 10, ln = (e >> 4) & 63, v0 = e & 15;
          f32x4 s = *(const LAS f32x4*)(part + e);
#pragma unroll
          for (int w = 1; w < 8; ++w) s = s + *(const LAS f32x4*)(part + w * 2048 + e);
          const int col = c0 + 32 * j + (ln & 31); const float gt = gate[col];
#pragma unroll
          for (int q = 0; q < 4; ++q) { const int v = v0 + q, row = cr0 + (v & 3) + 8 * (v >> 2) + 4 * (ln >> 5);
              const size_t o = (size_t)row * DM + col; xdst[o] = xsrc[o] + gt * s[q]; } }
        __syncthreads();
    }
}

DI void transpose_item(const float* W, int K, int N, bfu* WT, int mode, LAS float* scr, int item, int lane) {
    const int nblk = N / 32, kb = item / nblk, nb = item % nblk, k0 = 64 * kb, n0 = 32 * nb;
    int orow0 = n0;
    if (mode == 1) { const int isu = n0 >= FFN, j0 = isu ? n0 - FFN : n0; orow0 = (j0 >> 7) * 256 + isu * 128 + (j0 & 127); }
#pragma unroll 8
    for (int i = 0; i < 32; ++i) { const int kk = 2 * i + (lane >> 5); scr[kk * 33 + (lane & 31)] = W[(size_t)(k0 + kk) * N + n0 + (lane & 31)]; }
    LDS_WAIT(); asm volatile("" ::: "memory");
    const int c = lane & 7;
#pragma unroll
    for (int j = 0; j < 4; ++j) { const int n = (lane >> 3) + 8 * j; const LAS float* s = scr + (8 * c) * 33 + n;
        v4u o; o.x = pk2(s[0 * 33], s[1 * 33]); o.y = pk2(s[2 * 33], s[3 * 33]); o.z = pk2(s[4 * 33], s[5 * 33]); o.w = pk2(s[6 * 33], s[7 * 33]);
        *(v4u*)(WT + (size_t)(orow0 + n) * K + k0 + 8 * c) = o; }
    LDS_WAIT(); asm volatile("" ::: "memory");
}
DI void convert_weights(const float* W, int K, int N, bfu* WT, int mode, LAS unsigned char* lds, int bx, int G) {
    PHASE_IDS();
    LAS float* scr = (LAS float*)(lds + wave * 16384);
    const int nitems = (K / 64) * (N / 32);
    for (int it = gw; it < nitems; it += ngw) transpose_item(W, K, N, WT, mode, scr, it, lane);
}

DI void p_mods(const float* c, const float* cctx, const float* ada_w, const float* ada_b, float* mods, LAS float* sl, int bx, int G) {
    PHASE_IDS();
    LAS float* part = sl + 3 * DM;
    for (int i = tid; i < 3 * DM; i += NTHR) { const float v = (i < 2 * DM) ? c[i] : cctx[i - 2 * DM]; sl[i] = silu_f(v); }
    __syncthreads();
    for (int it = bx; it < 4 * 96; it += G) {
        const int l = it / 96, jb = it % 96, j = jb * 64 + lane, k0 = wave * 128;
        const float* wp = ada_w + ((size_t)l * DM + k0) * NMOD + j;
        float a0 = 0.f, a1 = 0.f, a2 = 0.f;
#pragma unroll 8
        for (int k = 0; k < 128; ++k) { const float w = wp[(size_t)k * NMOD]; a0 += sl[k0 + k] * w; a1 += sl[DM + k0 + k] * w; a2 += sl[2 * DM + k0 + k] * w; }
        part[(wave * 3 + 0) * 64 + lane] = a0; part[(wave * 3 + 1) * 64 + lane] = a1; part[(wave * 3 + 2) * 64 + lane] = a2;
        __syncthreads();
        if (tid < 192) { const int wh = tid >> 6; float s = ada_b[l * NMOD + j];
#pragma unroll
            for (int q = 0; q < 8; ++q) s += part[(q * 3 + wh) * 64 + lane];
            mods[((size_t)l * 3 + wh) * NMOD + j] = s; }
        __syncthreads();
    }
}

DI float* xrow(float* xlat, float* xctx, int r, int& which, bool& isctx) {
    const int b = r / SEGR, p = r % SEGR; isctx = p < CTXL; which = isctx ? 2 : b;
    return isctx ? xctx + (size_t)(b * CTXL + p) * DM : xlat + ((size_t)b * SEQ + (p - CTXL)) * DM;
}

template <bool COPY>
DI void p_norm(const float* slat, const float* sctx, float* dlat, float* dctx, const float* w, const float* mods_l, int o_sh, int o_sc, bfu* H, bool do_ctx, int bx, int G) {
    PHASE_IDS();
    int cur = -1; f32x4 av[4], bv[4];
#pragma unroll
    for (int j = 0; j < 4; ++j) { av[j] = (f32x4){0.f, 0.f, 0.f, 0.f}; bv[j] = av[j]; }
    for (int r = gw; r < MROWS; r += ngw) {
        int which; bool isctx; const float* xr = xrow((float*)slat, (float*)sctx, r, which, isctx);
        if (isctx && !do_ctx) continue;
        const f32x4* x4 = (const f32x4*)xr + lane;
        f32x4 v[4]; float s = 0.f;
#pragma unroll
        for (int j = 0; j < 4; ++j) v[j] = x4[64 * j];
        if (which != cur) { cur = which; const float* md = mods_l + which * NMOD;
#pragma unroll
            for (int j = 0; j < 4; ++j) { const int c = 4 * (lane + 64 * j);
                const f32x4 wv = *(const f32x4*)(w + c), sc = *(const f32x4*)(md + o_sc + c); av[j] = wv * (sc + 1.f); bv[j] = *(const f32x4*)(md + o_sh + c); } }
#pragma unroll
        for (int j = 0; j < 4; ++j) s += (v[j].x * v[j].x + v[j].y * v[j].y) + (v[j].z * v[j].z + v[j].w * v[j].w);
        const float rstd = __builtin_amdgcn_rsqf(wave_sum(s) * (1.f / DM) + EPS);
        if (COPY) { int w2; bool c2; f32x4* d4 = (f32x4*)xrow(dlat, dctx, r, w2, c2) + lane;
#pragma unroll
            for (int j = 0; j < 4; ++j) d4[64 * j] = v[j]; }
        v2u* o8 = (v2u*)(H + (size_t)r * DM) + lane;
#pragma unroll
        for (int j = 0; j < 4; ++j) { const f32x4 y = v[j] * rstd * av[j] + bv[j];
            v2u o; o.x = pk2(y.x, y.y); o.y = pk2(y.z, y.w); o8[64 * j] = o; }
    }
}
DI void p_final(float* xlat, const float* w, int bx, int G) {
    PHASE_IDS();
    f32x4 wv4[4];
#pragma unroll
    for (int j = 0; j < 4; ++j) wv4[j] = *(const f32x4*)(w + 4 * (lane + 64 * j));
    for (int r = gw; r < NBATCH * SEQ; r += ngw) {
        f32x4* x4 = (f32x4*)(xlat + (size_t)r * DM) + lane;
        f32x4 v[4]; float s = 0.f;
#pragma unroll
        for (int j = 0; j < 4; ++j) { v[j] = x4[64 * j]; s += (v[j].x * v[j].x + v[j].y * v[j].y) + (v[j].z * v[j].z + v[j].w * v[j].w); }
        const float rstd = 1.f / sqrtf(wave_sum(s) * (1.f / DM) + EPS);
#pragma unroll
        for (int j = 0; j < 4; ++j) x4[64 * j] = v[j] * rstd * wv4[j];
    }
}

DI void p_qkvpost(bfu* QKV, const float* qnorm, const float* knorm, int bx, int G) {
    PHASE_IDS();
    const int i = lane & 31, hh = lane >> 5, fi = i & 15;
    const float inv = exp2f(-(float)fi * (13.287712379549449f / 16.f));
    const float C2 = 0.125f * 1.4426950408889634f;
    const float qn0 = qnorm[2 * i], qn1 = qnorm[2 * i + 1], kn0 = knorm[2 * i], kn1 = knorm[2 * i + 1];
    for (int r = gw; r < MROWS; r += ngw) {
        const int p = r % SEGR; const bool isctx = p < CTXL; const int t = p - CTXL;
        float cs = 1.f, sn = 0.f;
        if (!isctx) { const float pos = (float)((i < 16) ? (t >> 6) : (t & 63)); const float ang = pos * inv;
            const float k = rintf(ang * 0.15915494309189535f); float rr = fmaf(-k, 6.2831854820251465f, ang); rr = fmaf(-k, -1.7484555e-7f, rr);
            cs = cosf(rr); sn = sinf(rr); }
        bfu* row = QKV + (size_t)r * NQKV;
        unsigned uu[13];
#pragma unroll
        for (int it = 0; it < 13; ++it) { const int hs = 2 * it + hh;
            const int col0 = (hs < 16) ? hs * 64 : (hs < 24 ? 1536 + (hs - 16) * 64 : 2048 + (hs - 24) * 64);
            uu[it] = *((const unsigned*)(row + col0) + i); }
#pragma unroll
        for (int it = 0; it < 13; ++it) {
            const int hs = 2 * it + hh;
            const int col0 = (hs < 16) ? hs * 64 : (hs < 24 ? 1536 + (hs - 16) * 64 : 2048 + (hs - 24) * 64);
            float x0 = bflo(uu[it]), x1 = bfhi(uu[it]);
            if (it >= 8) { const float ss = half_sum(x0 * x0 + x1 * x1); const float rstd = 1.f / sqrtf(ss * (1.f / 64.f) + EPS);
                x0 *= rstd * ((it < 12) ? qn0 : kn0); x1 *= rstd * ((it < 12) ? qn1 : kn1); }
            float y0 = x0 * cs - x1 * sn, y1 = x0 * sn + x1 * cs;
            if (it < 4 || (it >= 8 && it < 12)) { y0 *= C2; y1 *= C2; }
            *((unsigned*)(row + col0) + i) = pk2(y0, y1);
        }
    }
}

DI void attn_pair(const bfu* QKV, bfu* AOR, bfu* AO, int b, int hd, size_t qrow_off, int NT, float lam, const float* subln, float omli, char* lds) {
    using abf = attn_body::bf16;
    const size_t rb = (size_t)b * SEGR, rq = rb + qrow_off;
    const bfu* V = QKV + rb * NQKV + 1024 + hd * 128; bfu* O1 = AOR + rq * NAO + hd * 256;
    attn_body::attn_unit128<8, 0>((const abf*)(QKV + rq * NQKV + hd * 64), (const abf*)(QKV + rb * NQKV + 512 + hd * 64), (const abf*)V, (abf*)O1, NT, lds, nullptr, nullptr, 0.f, nullptr, 0.f);
    attn_body::attn_unit128<8, 1>((const abf*)(QKV + rq * NQKV + 256 + hd * 64), (const abf*)(QKV + rb * NQKV + 768 + hd * 64), (const abf*)V, (abf*)O1, NT, lds, (const abf*)O1, (abf*)(AO + rq * DM + hd * 128), lam, subln, omli);
}
DI void attn_gqa(const bfu* QKV, bfu* AO, int b, int hq, size_t qrow_off, int NT, char* lds) {
    using abf = attn_body::bf16;
    const size_t rb = (size_t)b * SEGR, rq = rb + qrow_off; const int g = hq >> 2;
    attn_body::attn_unit<8>((const abf*)(QKV + rq * NQKV + 1536 + hq * 64), (const abf*)(QKV + rb * NQKV + 2048 + g * 64), (const abf*)(QKV + rb * NQKV + 2176 + g * 64), (abf*)(AO + rq * DM + 512 + hq * 64), DM, NT, lds);
}
DI void p_attn(const bfu* QKV, bfu* AOR, bfu* AO, const float* lq1, const float* lk1, const float* lq2, const float* lk2, const float* subln, float lam_init, bool ctx_out, char* lds, int bx, int G, int vcu, int xmap) {
    PHASE_IDS();
    const float lam = __expf(wave_sum(lq1[lane] * lk1[lane])) - __expf(wave_sum(lq2[lane] * lk2[lane])) + lam_init, omli = 1.f - lam_init;
    const int npair = 8 * 64 + (ctx_out ? 8 : 0), ngqa = 16 * 64 + (ctx_out ? 16 : 0);
    for (int i = 0;; ++i) {
        int u;
        if (xmap) { if (i >= 2) { u = 512 + (i - 2) * G + bx; if (u < 512 || i > 2 || !(u < npair)) break; } else u = (vcu >> 5) * 64 + i * 32 + (vcu & 31); }
        else { u = i * G + bx; if (u >= npair) break; }
        if (u < 512) attn_pair(QKV, AOR, AO, (u >> 6) >> 2, (u >> 6) & 3, CTXL + (size_t)(u & 63) * 256, SEGR / 64, lam, subln, omli, lds);
        else attn_pair(QKV, AOR, AO, (u - 512) >> 2, (u - 512) & 3, 0, CTXL / 64, lam, subln, omli, lds);
    }
    for (int i = 0;; ++i) {
        int u;
        if (xmap) { if (i >= 4) { u = 1024 + (i - 4) * G + bx; if (i > 4 || !(u < ngqa)) break; } else u = (2 * (vcu >> 5) + (i >> 1)) * 64 + (i & 1) * 32 + (vcu & 31); }
        else { u = i * G + bx; if (u >= ngqa) break; }
        if (u < 1024) attn_gqa(QKV, AO, (u >> 6) >> 3, (u >> 6) & 7, CTXL + (size_t)(u & 63) * 256, SEGR / 64, lds);
        else attn_gqa(QKV, AO, (u - 1024) >> 3, (u - 1024) & 7, 0, CTXL / 64, lds);
    }
}

DI void p_sgu_mix(const bfu* UV, const float* part, const float* vnorm, const bfu* Wsb, const float* bs, bfu* So, bool do_ctx, LAS unsigned char* lds, int bx, int G) {
    PHASE_IDS();
    const int w = wave, r32 = lane & 31, hi = lane >> 5;
    constexpr int VS = 264;
    LAS bfu* Vr = (LAS bfu*)lds; LAS float* rsl = (LAS float*)(lds + 69632);
    const int c8 = (tid & 31) * 8;
    int gcur = -1; bf16x8 afr[4][8];
    for (int it = bx; it < (MROWS / 128) * 4; it += G) {
        const int n = it >> 2, g = it & 3, R0 = n * 128, c0 = g * 256;
        if (!do_ctx && (R0 % SEGR) < CTXL) continue;
        const f32x4 n0 = *(const f32x4*)(vnorm + c0 + c8), n1 = *(const f32x4*)(vnorm + c0 + c8 + 4);
        v4u vin[8]; float rsv[8];
#pragma unroll
        for (int k = 0; k < 8; ++k) { const int q = (tid >> 5) + 16 * k; vin[k] = *(const v4u*)(UV + (size_t)(R0 + q) * 2048 + 1024 + c0 + c8); }
        if (tid < 128) { const f32x4* pp = (const f32x4*)(part + (size_t)(R0 + tid) * 16); const f32x4 p0 = pp[0], p1 = pp[1], p2 = pp[2], p3 = pp[3];
            float s = p0.x; s += p0.y; s += p0.z; s += p0.w; s += p1.x; s += p1.y; s += p1.z; s += p1.w; s += p2.x; s += p2.y; s += p2.z; s += p2.w; s += p3.x; s += p3.y; s += p3.z; s += p3.w;
            rsl[tid] = 1.f / sqrtf(s * (1.f / DM) + EPS); }
        __syncthreads();
#pragma unroll
        for (int k = 0; k < 8; ++k) rsv[k] = rsl[(tid >> 5) + 16 * k];
        if (g != gcur) { gcur = g; const bfu* Wg = Wsb + (size_t)g * 16384;
#pragma unroll
            for (int pb = 0; pb < 4; ++pb)
#pragma unroll
                for (int ks = 0; ks < 8; ++ks) afr[pb][ks] = *(const bf16x8*)(Wg + (32 * pb + r32) * 128 + 16 * ks + 8 * hi); }
#pragma unroll
        for (int k = 0; k < 8; ++k) { const int q = (tid >> 5) + 16 * k; const v4u u = vin[k]; const float rs = rsv[k];
            v4u o; o.x = pk2(bflo(u.x) * rs * n0.x, bfhi(u.x) * rs * n0.y); o.y = pk2(bflo(u.y) * rs * n0.z, bfhi(u.y) * rs * n0.w);
            o.z = pk2(bflo(u.z) * rs * n1.x, bfhi(u.z) * rs * n1.y); o.w = pk2(bflo(u.w) * rs * n1.z, bfhi(u.w) * rs * n1.w);
            *(LAS v4u*)(Vr + q * VS + c8) = o; }
        __syncthreads();
        f32x16 acc[4];
#pragma unroll
        for (int pb = 0; pb < 4; ++pb) acc[pb] = f32x16{};
        const int cl = 32 * w + r32;
#pragma unroll
        for (int ks = 0; ks < 8; ++ks) {
            const LAS bfu* vp = Vr + (16 * ks + 8 * hi) * VS + cl;
            v4u bw; bw.x = (unsigned)vp[0] | ((unsigned)vp[VS] << 16); bw.y = (unsigned)vp[2 * VS] | ((unsigned)vp[3 * VS] << 16);
            bw.z = (unsigned)vp[4 * VS] | ((unsigned)vp[5 * VS] << 16); bw.w = (unsigned)vp[6 * VS] | ((unsigned)vp[7 * VS] << 16);
            const bf16x8 bfr = __builtin_bit_cast(bf16x8, bw);
#pragma unroll
            for (int pb = 0; pb < 4; ++pb) acc[pb] = __builtin_amdgcn_mfma_f32_32x32x16_bf16(afr[pb][ks], bfr, acc[pb], 0, 0, 0);
        }
        const int c = c0 + cl;
#pragma unroll
        for (int pb = 0; pb < 4; ++pb) {
            unsigned short ur[16]; float bb[16];
#pragma unroll
            for (int v = 0; v < 16; ++v) { const int p = 32 * pb + (v & 3) + 8 * (v >> 2) + 4 * hi; ur[v] = UV[(size_t)(R0 + p) * 2048 + c]; bb[v] = bs[g * 128 + p]; }
#pragma unroll
            for (int v = 0; v < 16; ++v) { const int p = 32 * pb + (v & 3) + 8 * (v >> 2) + 4 * hi;
                const float uu = __builtin_bit_cast(float, (unsigned)ur[v] << 16);
                So[(size_t)(R0 + p) * DM + c] = (bfu)f2bf(uu * (acc[pb][v] + bb[v])); }
        }
        __syncthreads();
    }
}

DI void p_convfix(const bfu* ZB, bfu* ACT, const float* cw, const float* cb, bool do_ctx, int bx, int G) {
    PHASE_IDS();
    constexpr int CPR = FFN / 8;
    const int nitems = (MROWS / 16) * CPR;
    for (int it = bx * NTHR + tid; it < nitems; it += G * NTHR) {
        const int k = it / CPR, ch = it % CPR, j = ch * 8, pn = j >> 7, jt = j & 127;
        const int r0 = k * 16, p0 = r0 % SEGR;
        if (!do_ctx && p0 < CTXL) continue;
        const bool first = (p0 == 0) || (p0 == CTXL), last = (p0 + 16 == CTXL) || (p0 + 16 == SEGR);
        const bfu* zb = ZB + (size_t)k * 4 * (2 * FFN) + pn * 256 + jt;
        const v4u zero = (v4u){0u, 0u, 0u, 0u};
        v4u zg[6], zu[6];
        if (first) { zg[0] = zero; zu[0] = zero; } else { zg[0] = *(const v4u*)(zb - (2 * FFN)); zu[0] = *(const v4u*)(zb - (2 * FFN) + 128); }
#pragma unroll
        for (int q = 0; q < 4; ++q) { zg[1 + q] = *(const v4u*)(zb + (size_t)q * (2 * FFN)); zu[1 + q] = *(const v4u*)(zb + (size_t)q * (2 * FFN) + 128); }
        if (last) { zg[5] = zero; zu[5] = zero; } else { zg[5] = *(const v4u*)(zb + (size_t)4 * (2 * FFN)); zu[5] = *(const v4u*)(zb + (size_t)4 * (2 * FFN) + 128); }
        float wg[3][8], wu[3][8], bg[8], bu[8];
#pragma unroll
        for (int d = 0; d < 3; ++d) { const f32x4 a = *(const f32x4*)(cw + d * 2 * FFN + j), b = *(const f32x4*)(cw + d * 2 * FFN + j + 4), c = *(const f32x4*)(cw + d * 2 * FFN + FFN + j), e = *(const f32x4*)(cw + d * 2 * FFN + FFN + j + 4);
            wg[d][0] = a.x; wg[d][1] = a.y; wg[d][2] = a.z; wg[d][3] = a.w; wg[d][4] = b.x; wg[d][5] = b.y; wg[d][6] = b.z; wg[d][7] = b.w;
            wu[d][0] = c.x; wu[d][1] = c.y; wu[d][2] = c.z; wu[d][3] = c.w; wu[d][4] = e.x; wu[d][5] = e.y; wu[d][6] = e.z; wu[d][7] = e.w; }
        { const f32x4 a = *(const f32x4*)(cb + j), b = *(const f32x4*)(cb + j + 4), c = *(const f32x4*)(cb + FFN + j), e = *(const f32x4*)(cb + FFN + j + 4);
            bg[0] = a.x; bg[1] = a.y; bg[2] = a.z; bg[3] = a.w; bg[4] = b.x; bg[5] = b.y; bg[6] = b.z; bg[7] = b.w;
            bu[0] = c.x; bu[1] = c.y; bu[2] = c.z; bu[3] = c.w; bu[4] = e.x; bu[5] = e.y; bu[6] = e.z; bu[7] = e.w; }
#pragma unroll
        for (int s = 0; s < 2; ++s) {
            const v4u gp = zg[3 * s], gc = zg[3 * s + 1], gn = zg[3 * s + 2], up = zu[3 * s], uc = zu[3 * s + 1], un = zu[3 * s + 2];
            float o[8];
#define CV(kk, P, LOHI) { const float zgv = wg[0][kk] * LOHI(gp.P) + wg[1][kk] * LOHI(gc.P) + wg[2][kk] * LOHI(gn.P) + bg[kk]; \
                          const float zuv = wu[0][kk] * LOHI(up.P) + wu[1][kk] * LOHI(uc.P) + wu[2][kk] * LOHI(un.P) + bu[kk]; o[kk] = silu_f(zgv) * zuv; }
            CV(0, x, bflo) CV(1, x, bfhi) CV(2, y, bflo) CV(3, y, bfhi) CV(4, z, bflo) CV(5, z, bfhi) CV(6, w, bflo) CV(7, w, bfhi)
#undef CV
            v4u ov; ov.x = pk2(o[0], o[1]); ov.y = pk2(o[2], o[3]); ov.z = pk2(o[4], o[5]); ov.w = pk2(o[6], o[7]);
            *(v4u*)(ACT + (size_t)(r0 + 15 * s) * FFN + j) = ov;
        }
    }
}

struct Args { const float* in[27]; float* out; unsigned char* ws; };
enum { I_X = 0, I_C, I_CTX, I_CCTX, I_ADAW, I_ADAB, I_MIXN, I_FFNN, I_FINN, I_AWIN, I_AWOUT, I_LQ1, I_LK1, I_LQ2, I_LK2, I_SUBLN, I_QN, I_KN,
       I_SWIN, I_SVN, I_SWS, I_SBS, I_SWOUT, I_FUP, I_FCW, I_FCB, I_FDN };

#ifndef PROBE_ATTN
#define PROBE_ATTN 1
#endif
#ifndef PROBE_SYNC
#define PROBE_SYNC 1
#endif
#ifndef PROBE_GEMM
#define PROBE_GEMM 1
#endif
#ifndef PROBE_MISC
#define PROBE_MISC 1
#endif
#ifndef PROBE_CONV
#define PROBE_CONV 1
#endif
#ifndef PROBE_ELT
#define PROBE_ELT 1
#endif
#define GSYNC() do { for (int rs_ = 0; rs_ < PROBE_SYNC; ++rs_) xcd_barrier(xbar); } while (0)
#define ELT(x) do { for (int re_ = 0; re_ < PROBE_ELT; ++re_) { x; } } while (0)
__global__ void __launch_bounds__(NTHR, 2) fwd_megakernel(Args a) {
    extern __shared__ __attribute__((aligned(16))) unsigned char lds_raw[];
    cg::grid_group grid = cg::this_grid();
    LAS unsigned char* lds = (LAS unsigned char*)lds_raw;
    const int G = gridDim.x, bx = blockIdx.x;
    unsigned char* ws = a.ws;
    float* mods = (float*)(ws + WS_MODS); float* ctxx = (float*)(ws + WS_CTXX); float* rstd = (float*)(ws + WS_RSTD);
    bfu* wmixa = (bfu*)(ws + WS_WMIXA); bfu* wmixb = (bfu*)(ws + WS_WMIXB); bfu* wmixs = (bfu*)(ws + WS_WMIXS);
    bfu* wup = (bfu*)(ws + WS_WUP); bfu* wdn = (bfu*)(ws + WS_WDN);
    bfu* H = (bfu*)(ws + WS_H); bfu* QKV = (bfu*)(ws + WS_QKV); bfu* AOR = (bfu*)(ws + WS_AORAW); bfu* AO = (bfu*)(ws + WS_AO);
    bfu* UV = (bfu*)(ws + WS_UV); bfu* SB = (bfu*)(ws + WS_S); bfu* ZB = (bfu*)(ws + WS_ZB); bfu* ACT = (bfu*)(ws + WS_ACT);
    float* xlat = a.out;
    volatile LAS unsigned* bst = (volatile LAS unsigned*)(lds + LDS_BYTES - 64);
    if (threadIdx.x < 2) bst[threadIdx.x] = 0u;
    __syncthreads();
    const XcdBarrier xbar = xcd_barrier_post((unsigned*)(ws + WS_BAR), bst);
    if (threadIdx.x == 0) { const unsigned xc = xb_xcc_id() & 7u; bst[2] = xc; bst[3] = atomicAdd((unsigned*)(ws + WS_BAR) + 3500 + xc, 1u); }

    for (int rc_ = 0; rc_ < PROBE_CONV; ++rc_) p_mods(a.in[I_C], a.in[I_CCTX], a.in[I_ADAW], a.in[I_ADAB], mods, (LAS float*)lds, bx, G);
    for (int rc_ = 0; rc_ < PROBE_CONV; ++rc_) convert_weights(a.in[I_AWIN], DM, NQKV, wmixa, 0, lds, bx, G);
    for (int rc_ = 0; rc_ < PROBE_CONV; ++rc_) convert_weights(a.in[I_AWOUT], DM, DM, wmixb, 0, lds, bx, G);
    if (gridDim.x == 0x7fffffffu) grid.sync();
    GSYNC();
    int cid = bx, vcu = bx, xmap = 0;
    { bool even = (G % 8 == 0);
      for (int j = 0; j < 8; ++j) even = even && (__hip_atomic_load((unsigned*)(ws + WS_BAR) + 3500 + j, __ATOMIC_RELAXED, __HIP_MEMORY_SCOPE_AGENT) == (unsigned)(G / 8));
      if (even) { const int xc = (int)bst[2], rk = (int)bst[3]; cid = rk * 8 + xc; vcu = xc * (G / 8) + rk; xmap = (G == 256); }
      cid = __builtin_amdgcn_readfirstlane(cid); vcu = __builtin_amdgcn_readfirstlane(vcu); xmap = __builtin_amdgcn_readfirstlane(xmap); }

#pragma unroll 1
    for (int l = 0; l < 4; ++l) {
        int bxl = cid, Gl = G, vcul = vcu; asm volatile("" : "+s"(bxl), "+s"(Gl), "+s"(vcul));
        const int li = l >> 1; const bool is_attn = (l & 1) == 0; const bool upd_ctx = l < 2;
        const bool ctx_in = is_attn || upd_ctx;
        const float* mods_l = mods + (size_t)l * 3 * NMOD;
        const float lam_init = (l == 0) ? 0.2f : 0.47071302f;

        if (l == 0) p_norm<false>(a.in[I_X], a.in[I_CTX], nullptr, nullptr, a.in[I_MIXN], mods_l, 0, DM, H, true, bxl, Gl);
        else ELT(p_norm<false>(xlat, ctxx, nullptr, nullptr, a.in[I_MIXN] + l * DM, mods_l, 0, DM, H, ctx_in, bxl, Gl));
        for (int rc_ = 0; rc_ < PROBE_CONV; ++rc_) convert_weights(a.in[I_FUP] + (size_t)l * DM * 2 * FFN, DM, 2 * FFN, wup, 1, lds, bxl, Gl);
        for (int rc_ = 0; rc_ < PROBE_CONV; ++rc_) convert_weights(a.in[I_FDN] + (size_t)l * FFN * DM, FFN, DM, wdn, 0, lds, bxl, Gl);
        GSYNC();

        if (is_attn) {
            { pg8::Gemm g{H, wmixa, MROWS, NQKV, DM}; RowSched S; S.init(NQKV, Gl, bxl, 0);
              pg8::EpiBf16<0> E{QKV, NQKV, nullptr, 0, 0, 1.f};
              for (int rg_ = 0; rg_ < PROBE_GEMM; ++rg_) pg8::gemm_phase<pg8::EpiBf16<0>, RowSched, true, true>(lds, g, S, E); }
            GSYNC();
            p_qkvpost(QKV, a.in[I_QN] + li * 64, a.in[I_KN] + li * 64, bxl, Gl);
#ifdef PROBE_POST
            for (int rp_ = 0; rp_ < PROBE_POST; ++rp_) p_qkvpost(AOR, a.in[I_QN] + li * 64, a.in[I_KN] + li * 64, bxl, Gl);
#endif
            GSYNC();
            for (int rep_ = 0; rep_ < PROBE_ATTN; ++rep_) p_attn(QKV, AOR, AO, a.in[I_LQ1] + li * 64, a.in[I_LK1] + li * 64, a.in[I_LQ2] + li * 64, a.in[I_LK2] + li * 64, a.in[I_SUBLN] + li * 128, lam_init, upd_ctx, (char*)lds_raw, bxl, Gl, vcul, xmap);
            GSYNC();
        } else {
            { pg8::Gemm g{H, wmixa, MROWS, 2 * DM, DM}; RowSched S; S.init(2 * DM, Gl, bxl, !upd_ctx);
              EpiGeluV E{UV, rstd};
              pg8::gemm_phase<EpiGeluV, RowSched, true, true>(lds, g, S, E); }
            GSYNC();
            for (int rm_ = 0; rm_ < PROBE_MISC; ++rm_) p_sgu_mix(UV, rstd, a.in[I_SVN] + li * DM, wmixs, a.in[I_SBS] + li * 512, SB, upd_ctx, lds, bxl, Gl);
            GSYNC();
        }
        if (upd_ctx) p_ctx_resid<8>(is_attn ? AO : SB, DM, wmixb, l == 0 ? a.in[I_CTX] : ctxx, ctxx, mods_l + 2 * NMOD + 2 * DM, lds, bxl, Gl);
        { pg8::Gemm g{is_attn ? AO : SB, wmixb, MROWS, DM, DM}; RowSched S; S.init(DM, Gl, bxl, 1);
#ifdef PROBE_RES
          { EpiResid E2{xlat, ctxx, (float*)(ws + WS_BIG) + 512 * 1024, (float*)(ws + WS_BIG), mods_l + 2 * DM}; pg8::gemm_phase<EpiResid, RowSched, true, true>(lds, g, S, E2); }
#endif
          EpiResid E{l == 0 ? a.in[I_X] : xlat, l == 0 ? a.in[I_CTX] : ctxx, xlat, ctxx, mods_l + 2 * DM};
          pg8::gemm_phase<EpiResid, RowSched, true, true>(lds, g, S, E); }
        GSYNC();

        ELT(p_norm<false>(xlat, ctxx, nullptr, nullptr, a.in[I_FFNN] + l * DM, mods_l, 3 * DM, 4 * DM, H, upd_ctx, bxl, Gl));
        if (l < 3) {
            const int nl = l + 1, ni = nl >> 1;
            if ((nl & 1) == 0) {
                for (int rc_ = 0; rc_ < PROBE_CONV; ++rc_) convert_weights(a.in[I_AWIN] + (size_t)ni * DM * NQKV, DM, NQKV, wmixa, 0, lds, bxl, Gl);
                for (int rc_ = 0; rc_ < PROBE_CONV; ++rc_) convert_weights(a.in[I_AWOUT] + (size_t)ni * DM * DM, DM, DM, wmixb, 0, lds, bxl, Gl);
            } else {
                for (int rc_ = 0; rc_ < PROBE_CONV; ++rc_) convert_weights(a.in[I_SWIN] + (size_t)ni * DM * 2 * DM, DM, 2 * DM, wmixa, 0, lds, bxl, Gl);
                for (int rc_ = 0; rc_ < PROBE_CONV; ++rc_) convert_weights(a.in[I_SWOUT] + (size_t)ni * DM * DM, DM, DM, wmixb, 0, lds, bxl, Gl);
                const float* wsrc = a.in[I_SWS] + (size_t)ni * 65536;
                for (int e = bxl * NTHR + opaque_tid(); e < 32768; e += Gl * NTHR) ((unsigned*)wmixs)[e] = pk2(wsrc[2 * e], wsrc[2 * e + 1]);
            }
        }
        GSYNC();

        { pg8::Gemm g{H, wup, MROWS, 2 * FFN, DM}; RowSched S; S.init(2 * FFN, Gl, bxl, !upd_ctx);
          EpiConv E{ACT, ZB, a.in[I_FCW] + (size_t)l * 3 * 2 * FFN, a.in[I_FCB] + (size_t)l * 2 * FFN};
          pg8::gemm_phase<EpiConv, RowSched, true, true>(lds, g, S, E); }
        GSYNC();
        p_convfix(ZB, ACT, a.in[I_FCW] + (size_t)l * 3 * 2 * FFN, a.in[I_FCB] + (size_t)l * 2 * FFN, upd_ctx, bxl, Gl);
        GSYNC();
        if (upd_ctx) p_ctx_resid<11>(ACT, FFN, wdn, ctxx, ctxx, mods_l + 2 * NMOD + 5 * DM, lds, bxl, Gl);
        { pg8::Gemm g{ACT, wdn, MROWS, DM, FFN}; RowSched S; S.init(DM, Gl, bxl, 1, 2);
#ifdef PROBE_RES
          { EpiResid E2{xlat, ctxx, (float*)(ws + WS_BIG) + 512 * 1024, (float*)(ws + WS_BIG), mods_l + 5 * DM}; pg8::gemm_phase<EpiResid, RowSched, true, true>(lds, g, S, E2); }
#endif
          EpiResid E{xlat, ctxx, xlat, ctxx, mods_l + 5 * DM};
          pg8::gemm_phase<EpiResid, RowSched, true, true>(lds, g, S, E); }
        GSYNC();
    }
    p_final(xlat, a.in[I_FINN], cid, G);
}

extern "C" void kernel_launch(void* const* d_in, const int* in_sizes, int n_in, void* d_out, int out_size, void* d_ws, size_t ws_size, hipStream_t stream) {
    static int grid = 0;
    if (grid == 0) {
        if (n_in != 27 || ws_size < WS_END) { fprintf(stderr, "kernel_launch: unexpected n_in %d / ws %zu\n", n_in, ws_size); grid = -1; return; }
        int dev = 0, cus = 0, per_cu = 0;
        (void)hipGetDevice(&dev);
        (void)hipDeviceGetAttribute(&cus, hipDeviceAttributeMultiprocessorCount, dev);
        if (hipFuncSetAttribute((const void*)fwd_megakernel, hipFuncAttributeMaxDynamicSharedMemorySize, LDS_BYTES) != hipSuccess) { fprintf(stderr, "kernel_launch: hipFuncSetAttribute failed\n"); grid = -1; return; }
        if (hipOccupancyMaxActiveBlocksPerMultiprocessor(&per_cu, (const void*)fwd_megakernel, NTHR, LDS_BYTES) != hipSuccess || per_cu < 1) { fprintf(stderr, "kernel_launch: occupancy query gave %d\n", per_cu); per_cu = 1; }
        (void)hipGetLastError();
        grid = cus * 1;
    }
    if (grid < 0) return;
    (void)hipMemsetAsync((char*)d_ws + WS_BAR, 0, BAR_BYTES, stream);
    Args a{};
    for (int i = 0; i < 27; ++i) a.in[i] = (const float*)d_in[i];
    a.out = (float*)d_out; a.ws = (unsigned char*)d_ws;
    void* args[] = {&a};
    hipError_t e = hipLaunchCooperativeKernel((const void*)fwd_megakernel, dim3(grid), dim3(NTHR), args, LDS_BYTES, stream);
    if (e != hipSuccess) fprintf(stderr, "cooperative launch failed: %s (grid %d)\n", hipGetErrorString(e), grid);
}
```

```cpp
#include <hip/hip_runtime.h>
#include <hip/hip_bf16.h>
#include <hip/hip_cooperative_groups.h>
#include <cstdio>
#include <cstdint>
#include <cmath>
namespace cg = cooperative_groups;
namespace pg8 {
#define PG8_LAS __attribute__((address_space(3)))
typedef unsigned short bf16_t;
typedef short bf16x8 __attribute__((ext_vector_type(8)));
typedef float f32x4 __attribute__((ext_vector_type(4)));
typedef unsigned u32x4 __attribute__((ext_vector_type(4)));
constexpr int BM = 256, BK = 64, HALF = 128, HTB = HALF * BK * 2  , STAGE_BYTES = 8 * HTB, NXCD = 8, WGM = 4;

__host__ __device__ __forceinline__ int lds_byte(int r, int c) { const int st = (r >> 4) * 2 + (c >> 5), rr = r & 15, cc = c & 31, ob = rr * 64 + cc * 2; return st * 1024 + (ob ^ (((ob >> 9) & 1) << 5)); }
__host__ __device__ __forceinline__ void stage_rc(int b, int& R, int& C) { const int st = b / 1024, sb = b % 1024, swz = sb ^ (((sb >> 9) & 1) << 5); R = (st >> 1) * 16 + swz / 64; C = (st & 1) * 32 + (swz % 64) / 2; }
__host__ __device__ __forceinline__ int perm32(int rho) { const int n = rho >> 4, i = rho & 15; return 8 * (i >> 2) + 4 * n + (i & 3); }

struct Unit { int pm, pn; };
struct Gemm { const bf16_t* A; const bf16_t* Bt; int M, N, K; };

struct StaticOrder {
    int nM, nN, nwg, G, c;
    __host__ __device__ void init(int M, int N, int G_, int c_) { nM = M / BM; nN = N / BM; nwg = nM * nN; G = G_; c = c_; }
    __host__ __device__ bool next(int i, Unit& u) const {
        const long L = (long)i * G + c; if (L >= nwg) return false;
        int wgid = (int)L; { const int q = nwg / NXCD, r = nwg % NXCD, xcd = wgid % NXCD, off = wgid / NXCD; wgid = (xcd < r ? xcd * (q + 1) : r * (q + 1) + (xcd - r) * q) + off; }
        const int nig = WGM * nN, gid = wgid / nig, fm = gid * WGM, gsz = (nM - fm) < WGM ? (nM - fm) : WGM;
        u.pm = fm + ((wgid % nig) % gsz); u.pn = (wgid % nig) / gsz; return true;
    }
    __device__ __forceinline__ void a_ready(const Unit&) const {}
    __device__ __forceinline__ void done(const Unit&) const {}
};

__device__ __forceinline__ unsigned cvt_pk_bf16(float lo, float hi) { unsigned r; asm volatile("v_cvt_pk_bf16_f32 %0, %1, %2" : "=v"(r) : "v"(lo), "v"(hi)); return r; }
typedef float f32x2 __attribute__((ext_vector_type(2)));
__device__ __forceinline__ f32x2 gelu_pk(f32x2 v) {
    const f32x2 av = __builtin_elementwise_abs(v), d = av * 0.2316418882f + 1.0f;
    f32x2 t; t.x = __builtin_amdgcn_rcpf(d.x); t.y = __builtin_amdgcn_rcpf(d.y);
    f32x2 q = t * 0.5307027145f + (-0.7265760135f); q = q * t + 0.7107068705f; q = q * t + (-0.142248368f); q = q * t + 0.127414796f; q = q * t;
    const f32x2 s = (v * v) * (-0.72134752044f);
    f32x2 e; e.x = __builtin_amdgcn_exp2f(s.x); e.y = __builtin_amdgcn_exp2f(s.y);
    const f32x2 m = v * (q * e), r = v - m;
    f32x2 o; o.x = v.x < 0.f ? m.x : r.x; o.y = v.y < 0.f ? m.y : r.y; return o;
}

template <int ACT  > struct EpiBf16 {
    static constexpr bool PERM = true, AFTER_DRAIN = false; static_assert(ACT == 0 || ACT == 1, "EpiBf16: ACT is 0 (none) or 1 (gelu_pk)");
    bf16_t* O; int ldc; const float* bias; int split_cols; size_t split_stride; float scale0;
    __device__ __forceinline__ void operator()(const f32x4 (&acc)[2][2][4][2], const Unit& u, int wr, int wc, int fr, int fq) const {
        const int row0 = u.pm * BM + wr * 64 + fr; int colt = u.pn * BM; bf16_t* base = O;
        float sc = 1.f; if (split_cols) { const int t = colt / split_cols; base += (size_t)t * split_stride; colt -= t * split_cols; if (t == 0) sc = scale0; }
        const int col0 = colt + wc * 32 + 8 * fq, bcol0 = u.pn * BM + wc * 32 + 8 * fq;
        f32x4 bv[2][2];
#pragma unroll
        for (int bj = 0; bj < 2; ++bj)
#pragma unroll
            for (int n = 0; n < 2; ++n) bv[bj][n] = bias ? *(const f32x4*)(bias + bcol0 + bj * HALF + 4 * n) : (f32x4){0.f, 0.f, 0.f, 0.f};
#pragma unroll
        for (int ai = 0; ai < 2; ++ai)
#pragma unroll
            for (int m = 0; m < 4; ++m) { bf16_t* rowp = base + (size_t)(row0 + ai * HALF + m * 16) * ldc + col0;
#pragma unroll
                for (int bj = 0; bj < 2; ++bj) { f32x4 v0 = acc[ai][bj][m][0] + bv[bj][0], v1 = acc[ai][bj][m][1] + bv[bj][1];
                    if (ACT == 1) { f32x2 a = gelu_pk((f32x2){v0[0], v0[1]}), b = gelu_pk((f32x2){v0[2], v0[3]}), c = gelu_pk((f32x2){v1[0], v1[1]}), d = gelu_pk((f32x2){v1[2], v1[3]});
                        v0 = (f32x4){a.x, a.y, b.x, b.y}; v1 = (f32x4){c.x, c.y, d.x, d.y}; }
                    v0 = v0 * sc; v1 = v1 * sc; u32x4 w; w.x = cvt_pk_bf16(v0[0], v0[1]); w.y = cvt_pk_bf16(v0[2], v0[3]); w.z = cvt_pk_bf16(v1[0], v1[1]); w.w = cvt_pk_bf16(v1[2], v1[3]);
                    *(u32x4*)(rowp + bj * HALF) = w; } }
    }
};
template <class Epi, class Sched, bool ALIGN_EPI = false, bool SP2 = false>
__device__ __forceinline__ void gemm_phase(PG8_LAS unsigned char* lds, const Gemm g, const Sched& S, const Epi& E) {
    int tid_ = threadIdx.x; asm volatile("" : "+v"(tid_));
    const int tid = tid_, wid = __builtin_amdgcn_readfirstlane(tid >> 6), lane = tid & 63, wr = wid >> 2, wc = wid & 3, fr = lane & 15, fq = lane >> 4;
    const int K = g.K, nt = K / BK;
    unsigned voffA[2], voffB[2];
#pragma unroll
    for (int i = 0; i < 2; ++i) { int R, C; stage_rc(tid * 16 + i * 8192, R, C); const int Rb = Epi::PERM ? ((R & ~31) + perm32(R & 31)) : R;
        voffA[i] = (unsigned)(R * K + C) * 2u; voffB[i] = (unsigned)(Rb * K + C) * 2u; }
    const size_t kstep = (size_t)(BK * 2);
    const size_t hstep = (size_t)HALF * K * 2;
    const size_t tstep = 2 * hstep;
    const unsigned ldsw = (unsigned)wid * 1024u;
    const int aoff = lds_byte(wr * 64 + fr, fq * 8), boff = lds_byte(wc * 32 + fr, fq * 8);
#define PG8_SA(b, h) (((b) * 2 + (h)) * HTB)
#define PG8_SB(b, h) ((4 + (b) * 2 + (h)) * HTB)
#define PG8_STAGE(bufoff, gbase, voff) do { _Pragma("unroll") for (int _i = 0; _i < 2; ++_i) \
        __builtin_amdgcn_global_load_lds((const unsigned*)((const char*)(gbase) + (voff)[_i]), (PG8_LAS unsigned*)(lds + (bufoff) + ldsw + _i * 8192), 16, 0, 0); } while (0)
#define PG8_LDA(dst, b, h) do { _Pragma("unroll") for (int m = 0; m < 4; ++m) _Pragma("unroll") for (int k = 0; k < 2; ++k) dst[m][k] = *(const PG8_LAS bf16x8*)(lds + PG8_SA(b, h) + aoff + m * 2048 + k * 1024); } while (0)
#define PG8_LDB(dst, b, h) do { _Pragma("unroll") for (int n = 0; n < 2; ++n) _Pragma("unroll") for (int k = 0; k < 2; ++k) dst[n][k] = *(const PG8_LAS bf16x8*)(lds + PG8_SB(b, h) + boff + n * 2048 + k * 1024); } while (0)
#define PG8_MMA(ai, bj, At, Bt) do { __builtin_amdgcn_s_setprio(1); _Pragma("unroll") for (int m = 0; m < 4; ++m) _Pragma("unroll") for (int n = 0; n < 2; ++n) _Pragma("unroll") for (int k = 0; k < 2; ++k) \
        acc[ai][bj][m][n] = __builtin_amdgcn_mfma_f32_16x16x32_bf16(Bt[n][k], At[m][k], acc[ai][bj][m][n], 0, 0, 0); __builtin_amdgcn_s_setprio(0); } while (0)
#define PG8_WAIT_V(n) asm volatile("s_waitcnt vmcnt(" #n ")" ::: "memory")
#define PG8_WAIT_L(n) asm volatile("s_waitcnt lgkmcnt(" #n ")" ::: "memory")
#define PG8_BAR __builtin_amdgcn_s_barrier()
#define PG8_SCHED __builtin_amdgcn_sched_barrier(0)
    Unit cur, nxt; int ui = 0;
    if (!S.next(0, cur)) return;
    f32x4 acc[2][2][4][2];
#pragma unroll
    for (int a = 0; a < 2; ++a)
#pragma unroll
        for (int b = 0; b < 2; ++b)
#pragma unroll
            for (int m = 0; m < 4; ++m)
#pragma unroll
                for (int n = 0; n < 2; ++n) acc[a][b][m][n] = (f32x4){0.f, 0.f, 0.f, 0.f};
    bf16x8 At[4][2], B0[2][2], B1[2][2];
    const char* cA = (const char*)g.A + (size_t)cur.pm * tstep; const char* cB = (const char*)g.Bt + (size_t)cur.pn * tstep;
    S.a_ready(cur);
    if constexpr (SP2) {
        PG8_STAGE(PG8_SB(0, 0), cB, voffB); PG8_STAGE(PG8_SB(0, 1), cB + hstep, voffB); PG8_STAGE(PG8_SA(0, 0), cA, voffA); PG8_STAGE(PG8_SA(0, 1), cA + hstep, voffA);
        if (wr == 1) PG8_BAR;
        PG8_WAIT_V(2); PG8_BAR;
        PG8_STAGE(PG8_SB(1, 0), cB + kstep, voffB); PG8_STAGE(PG8_SA(1, 0), cA + kstep, voffA); PG8_STAGE(PG8_SB(1, 1), cB + hstep + kstep, voffB);
        PG8_WAIT_V(6); PG8_BAR;
    } else {
        PG8_STAGE(PG8_SB(0, 0), cB, voffB); PG8_STAGE(PG8_SA(0, 0), cA, voffA); PG8_STAGE(PG8_SB(0, 1), cB + hstep, voffB); PG8_STAGE(PG8_SA(0, 1), cA + hstep, voffA);
        if (wr == 1) PG8_BAR;
        PG8_WAIT_V(4); PG8_BAR;
        PG8_STAGE(PG8_SB(1, 0), cB + kstep, voffB); PG8_STAGE(PG8_SA(1, 0), cA + kstep, voffA); PG8_STAGE(PG8_SB(1, 1), cB + hstep + kstep, voffB);
        PG8_WAIT_V(6); PG8_BAR;
    }
    for (;;) {
        const bool has_next = S.next(ui + 1, nxt);
        const char* nA = has_next ? (const char*)g.A + (size_t)nxt.pm * tstep : cA; const char* nB = has_next ? (const char*)g.Bt + (size_t)nxt.pn * tstep : cB;
        for (int t = 0; t < nt; t += 2) {
            const bool last = (t == nt - 2);
            const char* a1 = cA + (size_t)(t + 1) * kstep;
            const char* a2 = last ? nA : cA + (size_t)(t + 2) * kstep; const char* b2 = last ? nB : cB + (size_t)(t + 2) * kstep;
            const char* a3 = a2 + kstep; const char* b3 = b2 + kstep;
            if (last && has_next) S.a_ready(nxt);
            if constexpr (SP2) {
            PG8_LDB(B0, 0, 0); PG8_LDB(B1, 0, 1); PG8_SCHED; PG8_LDA(At, 0, 0); PG8_STAGE(PG8_SA(1, 1), a1 + hstep, voffA);
            PG8_WAIT_V(8); PG8_WAIT_L(0); PG8_BAR; PG8_MMA(0, 0, At, B0); PG8_MMA(0, 1, At, B1); PG8_BAR; PG8_SCHED;
            PG8_LDA(At, 0, 1); PG8_STAGE(PG8_SB(0, 0), b2, voffB); PG8_STAGE(PG8_SB(0, 1), b2 + hstep, voffB); PG8_STAGE(PG8_SA(0, 0), a2, voffA);
            PG8_WAIT_V(8); PG8_WAIT_L(0); PG8_BAR; PG8_MMA(1, 0, At, B0); PG8_MMA(1, 1, At, B1); PG8_BAR; PG8_SCHED;
            PG8_LDB(B0, 1, 0); PG8_LDB(B1, 1, 1); PG8_SCHED; PG8_LDA(At, 1, 0); PG8_STAGE(PG8_SA(0, 1), a2 + hstep, voffA);
            PG8_WAIT_V(8); PG8_WAIT_L(0); PG8_BAR; PG8_MMA(0, 0, At, B0); PG8_MMA(0, 1, At, B1); PG8_BAR; PG8_SCHED;
            PG8_LDA(At, 1, 1); PG8_STAGE(PG8_SB(1, 0), b3, voffB); PG8_STAGE(PG8_SB(1, 1), b3 + hstep, voffB); PG8_STAGE(PG8_SA(1, 0), a3, voffA);
            PG8_WAIT_V(8); PG8_WAIT_L(0); PG8_BAR; PG8_MMA(1, 0, At, B0); PG8_MMA(1, 1, At, B1); PG8_BAR; PG8_SCHED;
            } else {
            PG8_LDB(B0, 0, 0); PG8_SCHED; PG8_LDA(At, 0, 0); PG8_STAGE(PG8_SA(1, 1), a1 + hstep, voffA);
            PG8_WAIT_L(8); PG8_BAR; PG8_WAIT_L(0); PG8_MMA(0, 0, At, B0); PG8_BAR; PG8_SCHED;
            PG8_LDB(B1, 0, 1); PG8_STAGE(PG8_SB(0, 0), b2, voffB);
            PG8_BAR; PG8_WAIT_L(0); PG8_MMA(0, 1, At, B1); PG8_BAR;
            PG8_LDA(At, 0, 1); PG8_STAGE(PG8_SA(0, 0), a2, voffA);
            PG8_BAR; PG8_WAIT_L(0); PG8_MMA(1, 0, At, B0); PG8_BAR; PG8_SCHED;
            PG8_STAGE(PG8_SB(0, 1), b2 + hstep, voffB);
            PG8_WAIT_V(6); PG8_BAR; PG8_MMA(1, 1, At, B1); PG8_BAR;
            PG8_LDB(B0, 1, 0); PG8_SCHED; PG8_LDA(At, 1, 0); PG8_STAGE(PG8_SA(0, 1), a2 + hstep, voffA);
            PG8_WAIT_L(8); PG8_BAR; PG8_WAIT_L(0); PG8_MMA(0, 0, At, B0); PG8_BAR; PG8_SCHED;
            PG8_LDB(B1, 1, 1); PG8_STAGE(PG8_SB(1, 0), b3, voffB);
            PG8_BAR; PG8_WAIT_L(0); PG8_MMA(0, 1, At, B1); PG8_BAR;
            PG8_LDA(At, 1, 1); PG8_STAGE(PG8_SA(1, 0), a3, voffA);
            PG8_BAR; PG8_WAIT_L(0); PG8_MMA(1, 0, At, B0); PG8_BAR; PG8_SCHED;
            PG8_STAGE(PG8_SB(1, 1), b3 + hstep, voffB);
            PG8_WAIT_V(6); PG8_BAR; PG8_MMA(1, 1, At, B1); PG8_BAR;
            }
        }
        if constexpr (ALIGN_EPI) { if (wr == 0) PG8_BAR; }
        if constexpr (!Epi::AFTER_DRAIN) { E(acc, cur, wr, wc, fr, fq); S.done(cur); }
        if (!has_next) break;
#pragma unroll
        for (int a = 0; a < 2; ++a)
#pragma unroll
            for (int b = 0; b < 2; ++b)
#pragma unroll
                for (int m = 0; m < 4; ++m)
#pragma unroll
                    for (int n = 0; n < 2; ++n) acc[a][b][m][n] = (f32x4){0.f, 0.f, 0.f, 0.f};
        cur = nxt; cA = nA; cB = nB; ++ui;
        if constexpr (ALIGN_EPI) { if (wr == 1) PG8_BAR; }
    }
    PG8_WAIT_V(0);
    if constexpr (!ALIGN_EPI) { if (wr == 0) PG8_BAR; }
    PG8_BAR;
    if constexpr (Epi::AFTER_DRAIN) { E.fused(acc, cur, wr, wc, fr, fq, lds, wid, lane); S.done(cur); }
#undef PG8_SA
#undef PG8_SB
#undef PG8_STAGE
#undef PG8_LDA
#undef PG8_LDB
#undef PG8_MMA
#undef PG8_WAIT_V
#undef PG8_WAIT_L
#undef PG8_BAR
#undef PG8_SCHED
}
}
#include <hip/hip_bf16.h>
namespace attn_body {
using bf16=__hip_bfloat16;
using bf16x8=__attribute__((ext_vector_type(8)))short;
using s16x4=__attribute__((ext_vector_type(4)))short;
using f32x16=__attribute__((ext_vector_type(16)))float;
using u32x4=__attribute__((ext_vector_type(4)))unsigned;
constexpr int D=64,PQ=2304,PO=1536;
constexpr int NW=8,QBLK=32,QB=QBLK*NW,KVBLK=64;
__device__ __forceinline__ int crow(int r,int hi){return (r&3)+8*(r>>2)+4*hi;}
#define SBAR() __builtin_amdgcn_sched_barrier(0)
__device__ __forceinline__ void cmask(f32x16&p0,f32x16&p1,int jb,int qrel,int hi){
  const float NEG=-INFINITY; int kb=64*jb+4*hi;
  #pragma unroll
  for(int r=0;r<16;++r){int kv=kb+(r&3)+8*(r>>2); if(kv>qrel)p0[r]=NEG; if(kv+32>qrel)p1[r]=NEG;}
}

constexpr int NSLOT=3, SLOTB=8192;
constexpr int LDS_K=0, LDS_V=NSLOT*SLOTB, LDS_WS=2*NSLOT*SLOTB, LDS_OST=LDS_WS+NW*64*4, LDS_BYTES=LDS_OST+NW*4096;
constexpr float C2=0.125f*1.4426950408889634f;
__device__ __forceinline__ void glds16(const void*gsrc,unsigned lds_dst){unsigned keep;
  asm volatile("s_mov_b32 %0, m0\n\ts_mov_b32 m0, %2\n\ts_nop 0\n\tglobal_load_lds_dwordx4 %1, off\n\ts_mov_b32 m0, %0":"=&s"(keep):"v"(gsrc),"s"(lds_dst):"memory");}
__device__ __forceinline__ float max3f(float a,float b,float c){float r;asm("v_max3_f32 %0, %1, %2, %3":"=v"(r):"v"(a),"v"(b),"v"(c));return r;}
__device__ __forceinline__ float max2f(float a,float b){float r;asm("v_max_f32_e32 %0, %1, %2":"=v"(r):"v"(a),"v"(b));return r;}
__device__ __forceinline__ float fadd_s(float a,float b){float r;asm("v_add_f32_e32 %0, %1, %2":"=v"(r):"v"(a),"v"(b));return r;}
__device__ __forceinline__ float fsub_s(float a,float b){float r;asm("v_sub_f32_e32 %0, %1, %2":"=v"(r):"v"(a),"v"(b));return r;}
typedef float f32x2_t __attribute__((ext_vector_type(2))); typedef __bf16 bf16x2_t __attribute__((ext_vector_type(2)));
__device__ __forceinline__ unsigned cvtpk_s(float lo,float hi){f32x2_t v={lo,hi};bf16x2_t b=__builtin_convertvector(v,bf16x2_t);return __builtin_bit_cast(unsigned,b);}
#define WAIT_BAR(N) asm volatile("s_waitcnt vmcnt(" #N ") lgkmcnt(0)\n\ts_barrier":::"memory")

__device__ __forceinline__ void qkt(f32x16&p0,f32x16&p1,const char*Kslot,const bf16x8*qr,const f32x16&negm,int r32,int hi){
  const char*kb=Kslot+hi*1024+r32*16;
  #pragma unroll
  for(int d0=0;d0<4;++d0){
    const bf16x8 b0=*reinterpret_cast<const bf16x8*>(kb+d0*2048);
    const bf16x8 b1=*reinterpret_cast<const bf16x8*>(kb+d0*2048+512);
    if(d0==0){p0=__builtin_amdgcn_mfma_f32_32x32x16_bf16(b0,qr[0],negm,0,0,0);p1=__builtin_amdgcn_mfma_f32_32x32x16_bf16(b1,qr[0],negm,0,0,0);}
    else{p0=__builtin_amdgcn_mfma_f32_32x32x16_bf16(b0,qr[d0],p0,0,0,0);p1=__builtin_amdgcn_mfma_f32_32x32x16_bf16(b1,qr[d0],p1,0,0,0);}}
}
typedef __attribute__((address_space(3))) const char* lds_cptr;
typedef short v4i16_t __attribute__((ext_vector_type(4)));
__device__ __forceinline__ void kload8(bf16x8*kf,lds_cptr kp){
  kf[0]=*(const __attribute__((address_space(3))) bf16x8*)(kp);      kf[1]=*(const __attribute__((address_space(3))) bf16x8*)(kp+512);
  kf[2]=*(const __attribute__((address_space(3))) bf16x8*)(kp+2048); kf[3]=*(const __attribute__((address_space(3))) bf16x8*)(kp+2560);
  kf[4]=*(const __attribute__((address_space(3))) bf16x8*)(kp+4096); kf[5]=*(const __attribute__((address_space(3))) bf16x8*)(kp+4608);
  kf[6]=*(const __attribute__((address_space(3))) bf16x8*)(kp+6144); kf[7]=*(const __attribute__((address_space(3))) bf16x8*)(kp+6656);
}
__device__ __forceinline__ void kload2(bf16x8*kf,lds_cptr kp,int j){ kf[2*j]=*(const __attribute__((address_space(3))) bf16x8*)(kp+j*2048); kf[2*j+1]=*(const __attribute__((address_space(3))) bf16x8*)(kp+j*2048+512); }
__device__ __forceinline__ s16x4 vtr(lds_cptr p){ return __builtin_bit_cast(s16x4,__builtin_amdgcn_ds_read_tr16_b64_v4i16((__attribute__((address_space(3))) v4i16_t*)p)); }
__device__ __forceinline__ float rowmax(const f32x16&p0,const f32x16&p1){
  float a=max3f(p0[0],p0[1],p1[0]),b=max3f(p0[2],p0[3],p1[1]);a=max3f(a,p1[2],p1[3]);
  #pragma unroll
  for(int r=4;r<16;r+=4){a=max3f(a,p0[r],p0[r+1]);b=max3f(b,p0[r+2],p0[r+3]);a=max3f(a,p1[r],p1[r+1]);b=max3f(b,p1[r+2],p1[r+3]);}
  const float m=max2f(a,b);
  auto rr=__builtin_amdgcn_permlane32_swap(__float_as_uint(m),__float_as_uint(m),false,false);
  return max2f(__uint_as_float(rr[0]),__uint_as_float(rr[1]));
}
__device__ __forceinline__ void pv(f32x16*o,int vb,bf16x8 pa0,bf16x8 pa1,bf16x8 pa2,bf16x8 pa3){
  #pragma unroll
  for(int d0=0;d0<2;++d0){s16x4 lo[4],hi[4];
    #pragma unroll
    for(int ks=0;ks<4;++ks){
      asm volatile("ds_read_b64_tr_b16 %0,%1 offset:%c2":"=&v"(lo[ks]):"v"(vb),"i"(d0*4096+ks*1024):"memory");
      asm volatile("ds_read_b64_tr_b16 %0,%1 offset:%c2":"=&v"(hi[ks]):"v"(vb),"i"(d0*4096+ks*1024+512):"memory");}
    asm volatile("s_waitcnt lgkmcnt(0)":::"memory");SBAR();
    #define PK(k) (bf16x8){lo[k][0],lo[k][1],lo[k][2],lo[k][3],hi[k][0],hi[k][1],hi[k][2],hi[k][3]}
    o[d0]=__builtin_amdgcn_mfma_f32_32x32x16_bf16(pa0,PK(0),o[d0],0,0,0);
    o[d0]=__builtin_amdgcn_mfma_f32_32x32x16_bf16(pa1,PK(1),o[d0],0,0,0);
    o[d0]=__builtin_amdgcn_mfma_f32_32x32x16_bf16(pa2,PK(2),o[d0],0,0,0);
    o[d0]=__builtin_amdgcn_mfma_f32_32x32x16_bf16(pa3,PK(3),o[d0],0,0,0);
    #undef PK
  }
}

#ifndef ATTN_STORE16
#define ATTN_STORE16(p,v) (*(u32x4*)(p)=(v))
#endif
template<int THRL> __device__ __forceinline__ void attn_unit(const bf16*Qblk,const bf16*__restrict__ Kh,const bf16*__restrict__ Vh,bf16*Oblk,const int po,const int NT,char*shm){
  int tid_=threadIdx.x; asm volatile("":"+v"(tid_));
  const int tid=tid_,lane=tid&63,r32=lane&31,hi=lane>>5; const int wid=__builtin_amdgcn_readfirstlane(tid>>6);
  const bf16*Qw=Qblk+(long)wid*QBLK*PQ;
  const unsigned lds0=(unsigned)(uintptr_t)shm;
  float*wsf=(float*)(shm+LDS_WS)+wid*64;
  const bf16*ksrc=Kh+(long)lane*PQ+wid*8;
  const bf16*vsrc=Vh+(long)(16*(wid&3)+(lane>>2))*PQ+(wid>>2)*32+(lane&3)*8;
  const unsigned kdst=lds0+LDS_K+wid*1024, vdst=lds0+LDS_V+wid*1024;
  #define DMA_K(t,slot) glds16(ksrc+(long)(t)*KVBLK*PQ,(unsigned)__builtin_amdgcn_readfirstlane(kdst+(slot)))
  #define DMA_V(t,slot) glds16(vsrc+(long)(t)*KVBLK*PQ,(unsigned)__builtin_amdgcn_readfirstlane(vdst+(slot)))
  const int vb0=(int)(lds0+LDS_V)+((lane>>4)&1)*32+(lane&3)*8+(4*hi+((lane&15)>>2))*64;
  const char*Kbase=shm+LDS_K; bf16x8 kf[8];
  const lds_cptr shm3=(lds_cptr)shm; const lds_cptr kp0=shm3+LDS_K+hi*1024+r32*16; const lds_cptr vp0=shm3+LDS_V+((lane>>4)&1)*32+(lane&3)*8+(4*hi+((lane&15)>>2))*64;
  DMA_K(0,0);DMA_V(0,0);DMA_K(1,SLOTB);
  bf16x8 qr[4];
  #pragma unroll
  for(int d0=0;d0<4;++d0)qr[d0]=*reinterpret_cast<const bf16x8*>(&Qw[(long)r32*PQ+d0*16+hi*8]);
  float mhat=0.f,l_reg=0.f;f32x16 o[2];o[0]=f32x16{};o[1]=f32x16{};f32x16 negm=f32x16{};asm volatile("":"+v"(negm));
  #define CMASK(P0,P1,t) do{}while(0)
  bool resc=false;
  #define START(P0,P1) do{ const float rm=rowmax(P0,P1); resc=false; \
    { const float dl=rm; mhat=fadd_s(mhat,dl); \
      _Pragma("unroll") for(int r=0;r<16;++r){P0[r]=fsub_s(P0[r],dl);P1[r]=fsub_s(P1[r],dl);} \
      _Pragma("unroll") for(int r=0;r<16;++r)negm[r]=-mhat; asm volatile("":"+v"(negm)); } \
    _Pragma("unroll") for(int r=0;r<16;++r)P0[r]=__builtin_amdgcn_exp2f(P0[r]); }while(0)
  #define RESC() do{ if(resc){ asm volatile("s_waitcnt lgkmcnt(0)":::"memory"); \
      _Pragma("unroll") for(int d_=0;d_<2;++d_) _Pragma("unroll") for(int r=0;r<16;++r)o[d_][r]*=wsf[crow(r,hi)]; } }while(0)
  f32x16 pA0,pA1,pB0,pB1;
  int sl_prev=0,sl_cur=0,sl_next=SLOTB;
  #define ROT() do{sl_prev=sl_cur;sl_cur=sl_next;sl_next=(sl_next==(NSLOT-1)*SLOTB)?0:sl_next+SLOTB;}while(0)
  DMA_K(2,2*SLOTB);
  WAIT_BAR(3);
  qkt(pA0,pA1,Kbase,qr,negm,r32,hi);asm volatile("s_nop 15\n\ts_nop 7":"+v"(pA0),"+v"(pA1));CMASK(pA0,pA1,0);
  START(pA0,pA1);
  _Pragma("unroll") for(int r=0;r<16;++r)pA1[r]=__builtin_amdgcn_exp2f(pA1[r]);
  WAIT_BAR(0);
  DMA_K(3,0);DMA_V(1,SLOTB);
  ROT();
  kload8(kf,kp0+sl_cur);
  WAIT_BAR(2);
  s16x4 vlo[8],vhi[8]; u32x4 pw0,pw1,pw2,pw3;
  #define PKW(P,B) cvtpk_s(P[B],P[B+1])
  #define PAF(k) __builtin_bit_cast(bf16x8,pw##k)
  #define VFR(i) (bf16x8){vlo[i][0],vlo[i][1],vlo[i][2],vlo[i][3],vhi[i][0],vhi[i][1],vhi[i][2],vhi[i][3]}
  #define PIN(x) asm volatile("":"+v"(x))
  #define MX3(a,b,c) __builtin_fmaxf(__builtin_fmaxf((a),(b)),(c))
  #define GAPA(MF,A0,A1,A2,A3,W0,W1,PW) do{ MF; sacc+=A0; sacc+=A1; sacc+=A2; sacc+=A3; PIN(sacc); W0; W1; PIN(PW); SBAR(); }while(0)
  #define EX(v) __builtin_amdgcn_exp2f(v)
  #define GAPB(MF,X,B) do{ MF; X[B]=EX(X[B]); X[B+1]=EX(X[B+1]); X[B+2]=EX(X[B+2]); X[B+3]=EX(X[B+3]); PIN(X); SBAR(); }while(0)
  #define VRD(i) do{ vlo[i]=vtr(vp_+(((i)>>2)*4096+((i)&3)*1024)); vhi[i]=vtr(vp_+(((i)>>2)*4096+((i)&3)*1024+512)); }while(0)
  #define KRD(G,j) do{ if(G){ kload2(kf,kp0+sl_next,j); SBAR(); } }while(0)
  #define STEP(C0,C1,P0,P1,t,GK,GV,GL) do{ SBAR(); \
    const lds_cptr vp_=vp0+sl_prev; \
    VRD(0); SBAR(); float sacc=(P0[0]+P0[1]); \
    GAPA(C0=__builtin_amdgcn_mfma_f32_32x32x16_bf16(kf[0],qr[0],negm,0,0,0), P0[2],P0[3],P0[4],P0[5],     pw0[0]=PKW(P0,0), pw0[1]=PKW(P0,2), pw0); \
    VRD(4); SBAR(); GAPA(C1=__builtin_amdgcn_mfma_f32_32x32x16_bf16(kf[1],qr[0],negm,0,0,0), P0[6],P0[7],P0[8],P0[9],     pw0[2]=PKW(P0,4), pw0[3]=PKW(P0,6), pw0); \
    VRD(1); SBAR(); GAPA(C0=__builtin_amdgcn_mfma_f32_32x32x16_bf16(kf[2],qr[1],C0,0,0,0),   P0[10],P0[11],P0[12],P0[13], pw1[0]=PKW(P0,8), pw1[1]=PKW(P0,10), pw1); \
    VRD(5); SBAR(); GAPA(C1=__builtin_amdgcn_mfma_f32_32x32x16_bf16(kf[3],qr[1],C1,0,0,0),   P0[14],P0[15],P1[0],P1[1],   pw1[2]=PKW(P0,12),pw1[3]=PKW(P0,14), pw1); \
    VRD(2); SBAR(); GAPA(C0=__builtin_amdgcn_mfma_f32_32x32x16_bf16(kf[4],qr[2],C0,0,0,0),   P1[2],P1[3],P1[4],P1[5],     pw2[0]=PKW(P1,0), pw2[1]=PKW(P1,2), pw2); \
    VRD(6); SBAR(); GAPA(C1=__builtin_amdgcn_mfma_f32_32x32x16_bf16(kf[5],qr[2],C1,0,0,0),   P1[6],P1[7],P1[8],P1[9],     pw2[2]=PKW(P1,4), pw2[3]=PKW(P1,6), pw2); \
    VRD(3); SBAR(); GAPA(C0=__builtin_amdgcn_mfma_f32_32x32x16_bf16(kf[6],qr[3],C0,0,0,0),   P1[10],P1[11],P1[12],P1[13], pw3[0]=PKW(P1,8), pw3[1]=PKW(P1,10), pw3); \
    VRD(7); SBAR(); GAPA(C1=__builtin_amdgcn_mfma_f32_32x32x16_bf16(kf[7],qr[3],C1,0,0,0),   P1[14],P1[15],0.f,0.f,       pw3[2]=PKW(P1,12),pw3[3]=PKW(P1,14), pw3); \
    l_reg+=sacc; \
    if(GK){DMA_K((t)+3,sl_cur);} if(GV){DMA_V((t)+1,sl_next);} \
    CMASK(C0,C1,t); \
    { float a=MX3(C0[0],C0[1],C1[0]),b=MX3(C0[2],C0[3],C1[1]); a=MX3(a,C1[2],C1[3]); \
      _Pragma("unroll") for(int r=4;r<16;r+=4){a=MX3(a,C0[r],C0[r+1]);b=MX3(b,C0[r+2],C0[r+3]);a=MX3(a,C1[r],C1[r+1]);b=MX3(b,C1[r+2],C1[r+3]);} \
      float rm=__builtin_fmaxf(a,b); { auto rr=__builtin_amdgcn_permlane32_swap(__float_as_uint(rm),__float_as_uint(rm),false,false); rm=__builtin_fmaxf(__uint_as_float(rr[0]),__uint_as_float(rr[1])); } \
      resc=false; \
      if(__builtin_expect(__any(rm>(float)THRL),0)){ const float dl=__builtin_fmaxf(rm,0.f); mhat+=dl; \
        _Pragma("unroll") for(int r=0;r<16;++r){C0[r]-=dl;C1[r]-=dl;} \
        _Pragma("unroll") for(int r=0;r<16;++r)negm[r]=-mhat; asm volatile("":"+v"(negm)); \
        const float f=__builtin_amdgcn_exp2f(-dl); l_reg*=f; if(hi==0)wsf[r32]=f; resc=true; } } \
    SBAR(); \
    GAPB(o[0]=__builtin_amdgcn_mfma_f32_32x32x16_bf16(PAF(0),VFR(0),o[0],0,0,0), C0,0); \
    GAPB(o[1]=__builtin_amdgcn_mfma_f32_32x32x16_bf16(PAF(0),VFR(4),o[1],0,0,0), C0,4); \
    KRD(GL,0); GAPB(o[0]=__builtin_amdgcn_mfma_f32_32x32x16_bf16(PAF(1),VFR(1),o[0],0,0,0), C0,8); \
    KRD(GL,1); GAPB(o[1]=__builtin_amdgcn_mfma_f32_32x32x16_bf16(PAF(1),VFR(5),o[1],0,0,0), C0,12); \
    KRD(GL,2); GAPB(o[0]=__builtin_amdgcn_mfma_f32_32x32x16_bf16(PAF(2),VFR(2),o[0],0,0,0), C1,0); \
    KRD(GL,3); GAPB(o[1]=__builtin_amdgcn_mfma_f32_32x32x16_bf16(PAF(2),VFR(6),o[1],0,0,0), C1,4); \
    GAPB(o[0]=__builtin_amdgcn_mfma_f32_32x32x16_bf16(PAF(3),VFR(3),o[0],0,0,0), C1,8); \
    GAPB(o[1]=__builtin_amdgcn_mfma_f32_32x32x16_bf16(PAF(3),VFR(7),o[1],0,0,0), C1,12); \
    }while(0)
  int t=1;
  #undef CMASK
  #define CMASK(P0,P1,t) do{}while(0)
  for(;t+5<NT;t+=2){
    STEP(pB0,pB1,pA0,pA1,t,true,true,true);     WAIT_BAR(2); RESC(); ROT();
    STEP(pA0,pA1,pB0,pB1,t+1,true,true,true);   WAIT_BAR(2); RESC(); ROT();
  }
  #undef CMASK
  #define CMASK(P0,P1,t) do{}while(0)
  #define ENDW(tt) do{ if((tt)+3<NT){WAIT_BAR(2);} else if((tt)+2<NT){WAIT_BAR(1);} else {WAIT_BAR(0);} }while(0)
  for(;t+1<NT;t+=2){
    STEP(pB0,pB1,pA0,pA1,t,(t+3<NT),(t+1<NT),(t+1<NT));       ENDW(t);   RESC(); ROT();
    STEP(pA0,pA1,pB0,pB1,t+1,(t+4<NT),(t+2<NT),(t+2<NT));     ENDW(t+1); RESC(); ROT();
  }
  STEP(pB0,pB1,pA0,pA1,NT-1,false,false,false); RESC();
  { float sacc=pB0[0]+pB0[1]; _Pragma("unroll") for(int r=2;r<16;++r)sacc+=pB0[r]; _Pragma("unroll") for(int r=0;r<16;++r)sacc+=pB1[r]; l_reg+=sacc;
    pw0=(u32x4){PKW(pB0,0),PKW(pB0,2),PKW(pB0,4),PKW(pB0,6)};pw1=(u32x4){PKW(pB0,8),PKW(pB0,10),PKW(pB0,12),PKW(pB0,14)};pw2=(u32x4){PKW(pB1,0),PKW(pB1,2),PKW(pB1,4),PKW(pB1,6)};pw3=(u32x4){PKW(pB1,8),PKW(pB1,10),PKW(pB1,12),PKW(pB1,14)};
    SBAR(); pv(o,vb0+sl_cur,PAF(0),PAF(1),PAF(2),PAF(3)); }
  #undef PKW
  #undef PAF
  #undef VFR
  #undef PIN
  #undef MX3
  #undef GAPA
  #undef GAPB
  #undef EX
  #undef VRD
  #undef KRD
  #undef STEP
  #undef ENDW
  {auto rr=__builtin_amdgcn_permlane32_swap(__float_as_uint(l_reg),__float_as_uint(l_reg),false,false);l_reg=__uint_as_float(rr[0])+__uint_as_float(rr[1]);}
  if(hi==0)wsf[32+r32]=l_reg;asm volatile("s_waitcnt lgkmcnt(0)":::"memory");
  float rli[16];
  #pragma unroll
  for(int r=0;r<16;++r)rli[r]=__builtin_amdgcn_rcpf(wsf[32+crow(r,hi)]);
  bf16*Ow=Oblk+(long)wid*QBLK*po;
  { bf16*stg=(bf16*)(shm+LDS_OST)+wid*2048;
    #pragma unroll
    for(int r=0;r<16;++r){const int orow=crow(r,hi);
      #pragma unroll
      for(int d0=0;d0<2;++d0)stg[orow*64+d0*32+r32]=__float2bfloat16(o[d0][r]*rli[r]);}
    asm volatile("s_waitcnt lgkmcnt(0)":::"memory");
    #pragma unroll
    for(int i=0;i<4;++i){const int row=i*8+(lane>>3),ch=lane&7; const u32x4 v=*(const u32x4*)(stg+row*64+ch*8); ATTN_STORE16(Ow+(long)row*po+ch*8,v);} }
  asm volatile("s_waitcnt lgkmcnt(0)\n\ts_barrier":::"memory");
  #undef DMA_K
  #undef DMA_V
  #undef CMASK
  #undef START
  #undef RESC
  #undef ROT
}
constexpr int LDS_WS8=LDS_V+3*2*SLOTB, LDS_OST8=LDS_WS8+NW*64*4, LDS_BYTES8=LDS_OST8+NW*8192;
typedef float f32x4_t __attribute__((ext_vector_type(4)));
template<int THRL,int MODE> __device__ __forceinline__ void attn_unit128(const bf16*Qblk,const bf16*__restrict__ Kh,const bf16*__restrict__ Vh,bf16*Oblk,const int NT,char*shm,const bf16*O1blk,bf16*AOblk,const float lam,const float*sln,const float omli){
  int tid_=threadIdx.x; asm volatile("":"+v"(tid_));
  const int tid=tid_,lane=tid&63,r32=lane&31,hi=lane>>5; const int wid=__builtin_amdgcn_readfirstlane(tid>>6);
  const bf16*Qw=Qblk+(long)wid*QBLK*PQ;
  const unsigned lds0=(unsigned)(uintptr_t)shm;
  float*wsf=(float*)(shm+LDS_WS8)+wid*64;
  const unsigned koff=(unsigned)(lane*PQ+wid*8)*2u;
  const unsigned voff=(unsigned)((16*(wid&3)+(lane>>2))*PQ+(wid>>2)*32+(lane&3)*8)*2u;
  const unsigned kdst=lds0+LDS_K+wid*1024, vdst=lds0+LDS_V+wid*1024;
  #define DMA_K(t,slot) glds16((const char*)Kh+(size_t)(t)*(KVBLK*PQ*2)+koff,(unsigned)__builtin_amdgcn_readfirstlane(kdst+(slot)))
  #define DMA_V(t,slot) do{ glds16((const char*)Vh+(size_t)(t)*(KVBLK*PQ*2)+voff,(unsigned)__builtin_amdgcn_readfirstlane(vdst+2*(slot))); glds16((const char*)Vh+(size_t)(t)*(KVBLK*PQ*2)+128+voff,(unsigned)__builtin_amdgcn_readfirstlane(vdst+2*(slot)+8192)); }while(0)
  const char*Kbase=shm+LDS_K; bf16x8 kf[8];
  const lds_cptr shm3=(lds_cptr)shm; const lds_cptr kp0=shm3+LDS_K+hi*1024+r32*16; const lds_cptr vp0=shm3+LDS_V+((lane>>4)&1)*32+(lane&3)*8+(4*hi+((lane&15)>>2))*64;
  DMA_K(0,0);DMA_V(0,0);DMA_K(1,SLOTB);
  bf16x8 qr[4];
  #pragma unroll
  for(int d0=0;d0<4;++d0)qr[d0]=*reinterpret_cast<const bf16x8*>(&Qw[(long)r32*PQ+d0*16+hi*8]);
  float mhat=0.f,l_reg=0.f;f32x16 o[4];o[0]=f32x16{};o[1]=f32x16{};o[2]=f32x16{};o[3]=f32x16{};f32x16 negm=f32x16{};asm volatile("":"+v"(negm));
  #define CMASK(P0,P1,t) do{}while(0)
  bool resc=false;
  #define START(P0,P1) do{ const float rm=rowmax(P0,P1); resc=false; \
    { const float dl=rm; mhat=fadd_s(mhat,dl); \
      _Pragma("unroll") for(int r=0;r<16;++r){P0[r]=fsub_s(P0[r],dl);P1[r]=fsub_s(P1[r],dl);} \
      _Pragma("unroll") for(int r=0;r<16;++r)negm[r]=-mhat; asm volatile("":"+v"(negm)); } \
    _Pragma("unroll") for(int r=0;r<16;++r)P0[r]=__builtin_amdgcn_exp2f(P0[r]); }while(0)
  #define RESC() do{ if(resc){ asm volatile("s_waitcnt lgkmcnt(0)":::"memory"); \
      _Pragma("unroll") for(int d_=0;d_<4;++d_) _Pragma("unroll") for(int r=0;r<16;++r)o[d_][r]*=wsf[crow(r,hi)]; } }while(0)
  f32x16 pA0,pA1,pB0,pB1;
  int sl_prev=0,sl_cur=0,sl_next=SLOTB;
  #define ROT() do{sl_prev=sl_cur;sl_cur=sl_next;sl_next=(sl_next==(NSLOT-1)*SLOTB)?0:sl_next+SLOTB;}while(0)
  DMA_K(2,2*SLOTB);
  WAIT_BAR(4);
  qkt(pA0,pA1,Kbase,qr,negm,r32,hi);asm volatile("s_nop 15\n\ts_nop 7":"+v"(pA0),"+v"(pA1));CMASK(pA0,pA1,0);
  START(pA0,pA1);
  _Pragma("unroll") for(int r=0;r<16;++r)pA1[r]=__builtin_amdgcn_exp2f(pA1[r]);
  WAIT_BAR(0);
  DMA_K(3,0);DMA_V(1,SLOTB);
  ROT();
  kload8(kf,kp0+sl_cur);
  WAIT_BAR(3);
  s16x4 vlo[8],vhi[8]; u32x4 pw0,pw1,pw2,pw3;
  #define PKW(P,B) cvtpk_s(P[B],P[B+1])
  #define PAF(k) __builtin_bit_cast(bf16x8,pw##k)
  #define VFR(i) (bf16x8){vlo[i][0],vlo[i][1],vlo[i][2],vlo[i][3],vhi[i][0],vhi[i][1],vhi[i][2],vhi[i][3]}
  #define PIN(x) asm volatile("":"+v"(x))
  #define MX3(a,b,c) __builtin_fmaxf(__builtin_fmaxf((a),(b)),(c))
  #define GAPA(MF,A0,A1,A2,A3,W0,W1,PW) do{ MF; sacc+=A0; sacc+=A1; sacc+=A2; sacc+=A3; PIN(sacc); W0; W1; PIN(PW); SBAR(); }while(0)
  #define EX(v) __builtin_amdgcn_exp2f(v)
  #define GAPB(MF,X,B,RL) do{ MF; X[B]=EX(X[B]); X[B+1]=EX(X[B+1]); RL; PIN(X); SBAR(); }while(0)
  #define VRD(i) do{ vlo[i]=vtr(vp_+(((i)>>2)*4096+((i)&3)*1024)); vhi[i]=vtr(vp_+(((i)>>2)*4096+((i)&3)*1024+512)); }while(0)
  #define VRDH(i) do{ vlo[i]=vtr(vp_+((((i)>>2)+2)*4096+((i)&3)*1024)); vhi[i]=vtr(vp_+((((i)>>2)+2)*4096+((i)&3)*1024+512)); }while(0)
  #define NORL do{}while(0)
  #define KRD(G,j) do{ if(G){ kload2(kf,kp0+sl_next,j); SBAR(); } }while(0)
  #define STEP(C0,C1,P0,P1,t,GK,GV,GL) do{ SBAR(); \
    const lds_cptr vp_=vp0+2*sl_prev; \
    float sacc=(P0[0]+P0[1]); \
    GAPA(C0=__builtin_amdgcn_mfma_f32_32x32x16_bf16(kf[0],qr[0],negm,0,0,0), P0[2],P0[3],P0[4],P0[5],     pw0[0]=PKW(P0,0), pw0[1]=PKW(P0,2), pw0); \
    GAPA(C1=__builtin_amdgcn_mfma_f32_32x32x16_bf16(kf[1],qr[0],negm,0,0,0), P0[6],P0[7],P0[8],P0[9],     pw0[2]=PKW(P0,4), pw0[3]=PKW(P0,6), pw0); \
    GAPA(C0=__builtin_amdgcn_mfma_f32_32x32x16_bf16(kf[2],qr[1],C0,0,0,0),   P0[10],P0[11],P0[12],P0[13], pw1[0]=PKW(P0,8), pw1[1]=PKW(P0,10), pw1); \
    GAPA(C1=__builtin_amdgcn_mfma_f32_32x32x16_bf16(kf[3],qr[1],C1,0,0,0),   P0[14],P0[15],P1[0],P1[1],   pw1[2]=PKW(P0,12),pw1[3]=PKW(P0,14), pw1); \
    GAPA(C0=__builtin_amdgcn_mfma_f32_32x32x16_bf16(kf[4],qr[2],C0,0,0,0),   P1[2],P1[3],P1[4],P1[5],     pw2[0]=PKW(P1,0), pw2[1]=PKW(P1,2), pw2); \
    GAPA(C1=__builtin_amdgcn_mfma_f32_32x32x16_bf16(kf[5],qr[2],C1,0,0,0),   P1[6],P1[7],P1[8],P1[9],     pw2[2]=PKW(P1,4), pw2[3]=PKW(P1,6), pw2); \
    GAPA(C0=__builtin_amdgcn_mfma_f32_32x32x16_bf16(kf[6],qr[3],C0,0,0,0),   P1[10],P1[11],P1[12],P1[13], pw3[0]=PKW(P1,8), pw3[1]=PKW(P1,10), pw3); \
    GAPA(C1=__builtin_amdgcn_mfma_f32_32x32x16_bf16(kf[7],qr[3],C1,0,0,0),   P1[14],P1[15],0.f,0.f,       pw3[2]=PKW(P1,12),pw3[3]=PKW(P1,14), pw3); \
    l_reg+=sacc; \
    VRD(0);VRD(4);VRD(1);VRD(5); SBAR(); VRD(2);VRD(6);VRD(3);VRD(7); SBAR();     \
    if(GK){DMA_K((t)+3,sl_cur);} if(GV){DMA_V((t)+1,sl_next);} \
    { float a=MX3(C0[0],C0[1],C1[0]),b=MX3(C0[2],C0[3],C1[1]); a=MX3(a,C1[2],C1[3]); \
      _Pragma("unroll") for(int r=4;r<16;r+=4){a=MX3(a,C0[r],C0[r+1]);b=MX3(b,C0[r+2],C0[r+3]);a=MX3(a,C1[r],C1[r+1]);b=MX3(b,C1[r+2],C1[r+3]);} \
      float rm=__builtin_fmaxf(a,b); { auto rr=__builtin_amdgcn_permlane32_swap(__float_as_uint(rm),__float_as_uint(rm),false,false); rm=__builtin_fmaxf(__uint_as_float(rr[0]),__uint_as_float(rr[1])); } \
      resc=false; \
      if(__builtin_expect(__any(rm>(float)THRL),0)){ const float dl=__builtin_fmaxf(rm,0.f); mhat+=dl; \
        _Pragma("unroll") for(int r=0;r<16;++r){C0[r]-=dl;C1[r]-=dl;} \
        _Pragma("unroll") for(int r=0;r<16;++r)negm[r]=-mhat; asm volatile("":"+v"(negm)); \
        const float f=__builtin_amdgcn_exp2f(-dl); l_reg*=f; if(hi==0)wsf[r32]=f; resc=true; } } \
    SBAR(); \
    GAPB(o[0]=__builtin_amdgcn_mfma_f32_32x32x16_bf16(PAF(0),VFR(0),o[0],0,0,0), C0,0,  VRDH(0)); \
    GAPB(o[1]=__builtin_amdgcn_mfma_f32_32x32x16_bf16(PAF(0),VFR(4),o[1],0,0,0), C0,2,  VRDH(4)); \
    GAPB(o[0]=__builtin_amdgcn_mfma_f32_32x32x16_bf16(PAF(1),VFR(1),o[0],0,0,0), C0,4,  VRDH(1)); \
    GAPB(o[1]=__builtin_amdgcn_mfma_f32_32x32x16_bf16(PAF(1),VFR(5),o[1],0,0,0), C0,6,  VRDH(5)); \
    GAPB(o[0]=__builtin_amdgcn_mfma_f32_32x32x16_bf16(PAF(2),VFR(2),o[0],0,0,0), C0,8,  VRDH(2)); \
    GAPB(o[1]=__builtin_amdgcn_mfma_f32_32x32x16_bf16(PAF(2),VFR(6),o[1],0,0,0), C0,10, VRDH(6)); \
    GAPB(o[0]=__builtin_amdgcn_mfma_f32_32x32x16_bf16(PAF(3),VFR(3),o[0],0,0,0), C0,12, VRDH(3)); \
    GAPB(o[1]=__builtin_amdgcn_mfma_f32_32x32x16_bf16(PAF(3),VFR(7),o[1],0,0,0), C0,14, VRDH(7)); \
    GAPB(o[2]=__builtin_amdgcn_mfma_f32_32x32x16_bf16(PAF(0),VFR(0),o[2],0,0,0), C1,0,  NORL); \
    GAPB(o[3]=__builtin_amdgcn_mfma_f32_32x32x16_bf16(PAF(0),VFR(4),o[3],0,0,0), C1,2,  NORL); \
    KRD(GL,0); GAPB(o[2]=__builtin_amdgcn_mfma_f32_32x32x16_bf16(PAF(1),VFR(1),o[2],0,0,0), C1,4,  NORL); \
    KRD(GL,1); GAPB(o[3]=__builtin_amdgcn_mfma_f32_32x32x16_bf16(PAF(1),VFR(5),o[3],0,0,0), C1,6,  NORL); \
    KRD(GL,2); GAPB(o[2]=__builtin_amdgcn_mfma_f32_32x32x16_bf16(PAF(2),VFR(2),o[2],0,0,0), C1,8,  NORL); \
    KRD(GL,3); GAPB(o[3]=__builtin_amdgcn_mfma_f32_32x32x16_bf16(PAF(2),VFR(6),o[3],0,0,0), C1,10, NORL); \
    GAPB(o[2]=__builtin_amdgcn_mfma_f32_32x32x16_bf16(PAF(3),VFR(3),o[2],0,0,0), C1,12, NORL); \
    GAPB(o[3]=__builtin_amdgcn_mfma_f32_32x32x16_bf16(PAF(3),VFR(7),o[3],0,0,0), C1,14, NORL); \
    }while(0)
  int t=1;
  #undef CMASK
  #define CMASK(P0,P1,t) do{}while(0)
  for(;t+5<NT;t+=2){
    STEP(pB0,pB1,pA0,pA1,t,true,true,true);     WAIT_BAR(3); RESC(); ROT();
    STEP(pA0,pA1,pB0,pB1,t+1,true,true,true);   WAIT_BAR(3); RESC(); ROT();
  }
  #undef CMASK
  #define CMASK(P0,P1,t) do{}while(0)
  #define ENDW(tt) do{ if((tt)+3<NT){WAIT_BAR(3);} else if((tt)+2<NT){WAIT_BAR(2);} else {WAIT_BAR(0);} }while(0)
  for(;t+1<NT;t+=2){
    STEP(pB0,pB1,pA0,pA1,t,(t+3<NT),(t+1<NT),(t+1<NT));       ENDW(t);   RESC(); ROT();
    STEP(pA0,pA1,pB0,pB1,t+1,(t+4<NT),(t+2<NT),(t+2<NT));     ENDW(t+1); RESC(); ROT();
  }
  STEP(pB0,pB1,pA0,pA1,NT-1,false,false,false); RESC();
  { float sacc=pB0[0]+pB0[1]; _Pragma("unroll") for(int r=2;r<16;++r)sacc+=pB0[r]; _Pragma("unroll") for(int r=0;r<16;++r)sacc+=pB1[r]; l_reg+=sacc;
    pw0=(u32x4){PKW(pB0,0),PKW(pB0,2),PKW(pB0,4),PKW(pB0,6)};pw1=(u32x4){PKW(pB0,8),PKW(pB0,10),PKW(pB0,12),PKW(pB0,14)};pw2=(u32x4){PKW(pB1,0),PKW(pB1,2),PKW(pB1,4),PKW(pB1,6)};pw3=(u32x4){PKW(pB1,8),PKW(pB1,10),PKW(pB1,12),PKW(pB1,14)};
    SBAR(); { const int vb0=(int)(unsigned)(size_t)vp0; pv(o,vb0+2*sl_cur,PAF(0),PAF(1),PAF(2),PAF(3)); pv(o+2,vb0+2*sl_cur+8192,PAF(0),PAF(1),PAF(2),PAF(3)); } }
  #undef PKW
  #undef PAF
  #undef VFR
  #undef PIN
  #undef MX3
  #undef GAPA
  #undef GAPB
  #undef EX
  #undef VRD
  #undef VRDH
  #undef NORL
  #undef KRD
  #undef STEP
  #undef ENDW
  {auto rr=__builtin_amdgcn_permlane32_swap(__float_as_uint(l_reg),__float_as_uint(l_reg),false,false);l_reg=__uint_as_float(rr[0])+__uint_as_float(rr[1]);}
  if(hi==0)wsf[32+r32]=l_reg;asm volatile("s_waitcnt lgkmcnt(0)":::"memory");
  float rli[16];
  #pragma unroll
  for(int r=0;r<16;++r)rli[r]=__builtin_amdgcn_rcpf(wsf[32+crow(r,hi)]);
  bf16*Ow=Oblk+(long)wid*QBLK*PO;
  if constexpr(MODE==0)
  { bf16*stg=(bf16*)(shm+LDS_OST8)+wid*2048;
    #pragma unroll
    for(int h2=0;h2<2;++h2){
      #pragma unroll
      for(int r=0;r<16;++r){const int orow=crow(r,hi);
        #pragma unroll
        for(int d0=0;d0<2;++d0)stg[orow*64+d0*32+r32]=__float2bfloat16(o[2*h2+d0][r]*rli[r]);}
      asm volatile("s_waitcnt lgkmcnt(0)":::"memory");
      #pragma unroll
      for(int i=0;i<4;++i){const int row=i*8+(lane>>3),ch=lane&7; const u32x4 v=*(const u32x4*)(stg+row*64+ch*8); ATTN_STORE16(Ow+(long)row*PO+h2*64+ch*8,v);}
      asm volatile("s_waitcnt lgkmcnt(0)":::"memory");
    } }
  else {
    bf16*stg=(bf16*)(shm+LDS_OST8)+wid*4096;
    #pragma unroll
    for(int r=0;r<16;++r){const int orow=crow(r,hi);
      #pragma unroll
      for(int d0=0;d0<4;++d0)stg[orow*128+d0*32+r32]=__float2bfloat16(o[d0][r]*rli[r]);}
    asm volatile("s_waitcnt lgkmcnt(0)":::"memory");
    const int row=lane>>1,hf=lane&1;
    const bf16*O1w=O1blk+((long)wid*QBLK+row)*PO+hf*64; bf16*AOw=AOblk+((long)wid*QBLK+row)*1024+hf*64;
    u32x4 a2[8],a1[8];
    #pragma unroll
    for(int i=0;i<8;++i){a2[i]=*(const u32x4*)(stg+row*128+hf*64+i*8); a1[i]=*(const u32x4*)(O1w+i*8);}
    float x[64]; float ss=0.f;
    #pragma unroll
    for(int i=0;i<8;++i){
      #pragma unroll
      for(int c=0;c<4;++c){const unsigned u1=a1[i][c],u2=a2[i][c];
        const float lo=__uint_as_float(u1<<16)-lam*__uint_as_float(u2<<16), hi2=__uint_as_float(u1&0xffff0000u)-lam*__uint_as_float(u2&0xffff0000u);
        x[i*8+2*c]=lo; x[i*8+2*c+1]=hi2; ss+=lo*lo+hi2*hi2;}}
    ss+=__shfl_xor(ss,1);
    const float rstd=1.f/sqrtf(ss*(1.f/128.f)+1e-6f)*omli;
    #pragma unroll
    for(int i=0;i<8;++i){ const f32x4_t s0=*(const f32x4_t*)(sln+hf*64+i*8), s1=*(const f32x4_t*)(sln+hf*64+i*8+4);
      u32x4 w; w[0]=cvtpk_s(x[i*8]*rstd*s0[0],x[i*8+1]*rstd*s0[1]); w[1]=cvtpk_s(x[i*8+2]*rstd*s0[2],x[i*8+3]*rstd*s0[3]);
      w[2]=cvtpk_s(x[i*8+4]*rstd*s1[0],x[i*8+5]*rstd*s1[1]); w[3]=cvtpk_s(x[i*8+6]*rstd*s1[2],x[i*8+7]*rstd*s1[3]);
      ATTN_STORE16(AOw+i*8,w);}
    asm volatile("s_waitcnt lgkmcnt(0)":::"memory");
  }
  asm volatile("s_waitcnt lgkmcnt(0)\n\ts_barrier":::"memory");
  #undef DMA_K
  #undef DMA_V
  #undef CMASK
  #undef START
  #undef RESC
  #undef ROT
}
constexpr int ATTN_LDS_BYTES=LDS_BYTES;
#undef SBAR
#undef WAIT_BAR
}
#define GAS __attribute__((address_space(1)))
#define LAS __attribute__((address_space(3)))
typedef unsigned short bfu;
typedef unsigned v4u __attribute__((ext_vector_type(4)));
typedef unsigned v2u __attribute__((ext_vector_type(2)));
typedef float f32x4 __attribute__((ext_vector_type(4)));
typedef float f32x16 __attribute__((ext_vector_type(16)));
typedef short bf16x8 __attribute__((ext_vector_type(8)));
#define LDS_WAIT() asm volatile("s_waitcnt lgkmcnt(0)" ::: "memory")
#define DI __device__ __forceinline__

#define XB_TMO      128
#define XB_XCNT(j)  (256  + 64 * (j))
#define XB_XSUB(j)  (1280 + 64 * (j))
#define XB_XGEN(j)  (2304 + 64 * (j))
#define XB_TOP      3328
#define XB_TOPGEN   3392
#define XCD_BAR_WORDS 3456
#define XB_SPIN_CAP (1u << 18)

__device__ __forceinline__ unsigned xb_ld(unsigned* p)              { return __hip_atomic_load(p, __ATOMIC_RELAXED, __HIP_MEMORY_SCOPE_AGENT); }
__device__ __forceinline__ unsigned xb_add(unsigned* p, unsigned v) { return __hip_atomic_fetch_add(p, v, __ATOMIC_RELAXED, __HIP_MEMORY_SCOPE_AGENT); }
__device__ __forceinline__ unsigned xb_xcc_id() { return (unsigned)__builtin_amdgcn_s_getreg((3 << 11) | 20) & 0xFu; }
#define XB_SPIN(cond, bar) do { unsigned _sp = 0; while (cond) { __builtin_amdgcn_s_sleep(1); \
    if ((++_sp & 255u) == 0u) { if (xb_ld(&(bar)[XB_TMO])) break; if (_sp > XB_SPIN_CAP) { atomicAdd(&(bar)[XB_TMO], 1u); break; } } } } while (0)

struct XcdBarrier {
    unsigned* bar; unsigned x;
    volatile LAS unsigned* st;
};

__device__ __forceinline__ XcdBarrier xcd_barrier_post(unsigned* bar, volatile LAS unsigned* st) {
    XcdBarrier b; b.bar = bar; b.x = xb_xcc_id(); b.st = st;
    if (threadIdx.x == 0) (void)xb_add(&bar[XB_XCNT(b.x)], 1u);
    return b;
}
__device__ __forceinline__ void xcd_barrier_complete(unsigned* bar, unsigned x, unsigned& nloc, unsigned& nx) {
    const unsigned G = gridDim.x * gridDim.y * gridDim.z;
    unsigned sum, cnt, mine, sp = 0u;
    for (;;) {
        sum = 0u; cnt = 0u; mine = 0u;
#pragma unroll
        for (unsigned j = 0; j < 16; ++j) { const unsigned c = xb_ld(&bar[XB_XCNT(j)]); sum += c; cnt += (c > 0u) ? 1u : 0u; mine = (j == x) ? c : mine; }
        if (sum == G) break;
        __builtin_amdgcn_s_sleep(1);
        if ((++sp & 255u) == 0u) { if (xb_ld(&bar[XB_TMO])) break; if (sp > XB_SPIN_CAP) { atomicAdd(&bar[XB_TMO], 1u); break; } }
    }
    nloc = mine > 0u ? mine : 1u; nx = cnt > 0u ? cnt : 1u;
}

__device__ __forceinline__ void xcd_barrier(const XcdBarrier& b) {
    asm volatile("s_waitcnt vmcnt(0)" ::: "memory");
    __syncthreads();
    if (threadIdx.x == 0) {
        unsigned* bar = b.bar;
        __builtin_amdgcn_s_waitcnt(0);
        unsigned nloc = b.st[0], nx = b.st[1];
        if (nloc == 0u) { xcd_barrier_complete(bar, b.x, nloc, nx); b.st[0] = nloc; b.st[1] = nx; }
        const unsigned old = xb_add(&bar[XB_XSUB(b.x)], 1u);
        const unsigned gen = old / nloc;
        if (old + 1u == (gen + 1u) * nloc) {
            __builtin_amdgcn_fence(__ATOMIC_RELEASE, "agent");
            asm volatile("s_waitcnt vmcnt(0)" ::: "memory");
            const unsigned og = xb_add(&bar[XB_TOP], 1u);
            const unsigned tg = og / nx;
            if (og + 1u == (tg + 1u) * nx) xb_add(&bar[XB_TOPGEN], 1u);
            else XB_SPIN(xb_ld(&bar[XB_TOPGEN]) == tg, bar);
            __builtin_amdgcn_fence(__ATOMIC_ACQUIRE, "agent");
            xb_add(&bar[XB_XGEN(b.x)], 1u);
            asm volatile("s_waitcnt vmcnt(0)" ::: "memory");
        } else {
            XB_SPIN(xb_ld(&bar[XB_XGEN(b.x)]) == gen, bar);
            __builtin_amdgcn_fence(__ATOMIC_ACQUIRE, "agent");
            asm volatile("s_waitcnt vmcnt(0)" ::: "memory");
        }
    }
    __syncthreads();
}


constexpr int DM = 1024, NBATCH = 2, SEQ = 16384, CTXL = 256, SEGR = SEQ + CTXL, MROWS = NBATCH * SEGR;
constexpr int FFN = 2816, NQKV = 2304, NAO = 1536, NMOD = 6 * DM;
constexpr float EPS = 1e-6f;
constexpr int NWAVES = 8, NTHR = 512;
constexpr int LDS_BYTES = 147456;
constexpr size_t MiB = 1u << 20;
constexpr size_t WS_MODS = 0;
constexpr size_t WS_BAR = 512 * 1024, BAR_BYTES = 16384;
constexpr size_t WS_CTXX = 1 * MiB;
constexpr size_t WS_RSTD = 29 * MiB;
constexpr size_t WS_WMIXA = 4 * MiB, WS_WMIXB = 4 * MiB + 4608 * 1024, WS_WMIXS = 4 * MiB + 6656 * 1024;
constexpr size_t WS_WUP = 12 * MiB, WS_WDN = 23 * MiB;
constexpr size_t WS_H = 32 * MiB;
constexpr size_t WS_BIG = 98 * MiB;
constexpr size_t WS_QKV = WS_BIG, WS_AORAW = WS_BIG + 147 * MiB, WS_AO = WS_BIG + 245 * MiB;
constexpr size_t WS_UV = WS_BIG, WS_S = WS_BIG + 131 * MiB;
constexpr size_t WS_ZB = WS_BIG, WS_ACT = WS_BIG + 179 * MiB;
constexpr size_t WS_END = 456 * MiB;

DI unsigned f2bf(float f) { unsigned u = __builtin_bit_cast(unsigned, f); return (u + 0x7fffu + ((u >> 16) & 1u)) >> 16; }
typedef float f32x2_h __attribute__((ext_vector_type(2))); typedef __bf16 bf16x2_h __attribute__((ext_vector_type(2)));
DI unsigned pk2(float lo, float hi) { const f32x2_h v = {lo, hi}; return __builtin_bit_cast(unsigned, __builtin_convertvector(v, bf16x2_h)); }
DI float bflo(unsigned u) { return __builtin_bit_cast(float, u << 16); }
DI float bfhi(unsigned u) { return __builtin_bit_cast(float, u & 0xffff0000u); }
DI float wave_sum(float v) {
#pragma unroll
    for (int o = 1; o < 64; o <<= 1) v += __shfl_xor(v, o);
    return v;
}
DI float half_sum(float v) {
#pragma unroll
    for (int o = 1; o < 32; o <<= 1) v += __shfl_xor(v, o);
    return v;
}
DI float silu_f(float x) { return x * __builtin_amdgcn_rcpf(1.f + __builtin_amdgcn_exp2f(x * -1.4426950408889634f)); }
DI int opaque_tid() { int t = threadIdx.x; asm volatile("" : "+v"(t)); return t; }
#define PHASE_IDS() const int tid = opaque_tid(), lane = tid & 63, wave = __builtin_amdgcn_readfirstlane(tid >> 6), gw = bx * NWAVES + wave, ngw = G * NWAVES; (void)lane; (void)gw; (void)ngw; (void)wave

struct EpiResid {
    static constexpr bool PERM = false, AFTER_DRAIN = false;
    const float* slat; const float* sctx; float* xlat; float* xctx; const float* gate;
    DI void operator()(const pg8::f32x4 (&acc)[2][2][4][2], const pg8::Unit& u, int wr, int wc, int fr, int fq) const {
        const int b = u.pm / 65, pp = u.pm % 65;
        const size_t boff = (pp == 0) ? (size_t)(b * CTXL) * DM : ((size_t)b * SEQ + (size_t)(pp - 1) * 256) * DM;
        float* base = ((pp == 0) ? xctx : xlat) + boff; const float* sbase = ((pp == 0) ? sctx : slat) + boff;
        const float* gt = gate + ((pp == 0) ? 2 : b) * NMOD;
        const int row0 = wr * 64 + fr, col0 = u.pn * 256 + wc * 32 + 4 * fq;
        pg8::f32x4 gv[2][2];
#pragma unroll
        for (int bj = 0; bj < 2; ++bj)
#pragma unroll
            for (int n = 0; n < 2; ++n) gv[bj][n] = *(const pg8::f32x4*)(gt + col0 + bj * 128 + n * 16);
        pg8::f32x4 xa[2][2][2], xb[2][2][2];
#define RES_LOAD(X, ai, h) do { _Pragma("unroll") for (int mm = 0; mm < 2; ++mm) { const float* srow = sbase + (size_t)(row0 + (ai) * 128 + (2 * (h) + mm) * 16) * DM + col0; \
            _Pragma("unroll") for (int bj = 0; bj < 2; ++bj) _Pragma("unroll") for (int n = 0; n < 2; ++n) X[mm][bj][n] = *(const pg8::f32x4*)(srow + bj * 128 + n * 16); } } while (0)
#define RES_STORE(X, ai, h) do { _Pragma("unroll") for (int mm = 0; mm < 2; ++mm) { float* rowp = base + (size_t)(row0 + (ai) * 128 + (2 * (h) + mm) * 16) * DM + col0; \
            _Pragma("unroll") for (int bj = 0; bj < 2; ++bj) _Pragma("unroll") for (int n = 0; n < 2; ++n) *(pg8::f32x4*)(rowp + bj * 128 + n * 16) = X[mm][bj][n] + gv[bj][n] * acc[ai][bj][2 * (h) + mm][n]; } } while (0)
        RES_LOAD(xa, 0, 0); RES_LOAD(xb, 0, 1);
        RES_STORE(xa, 0, 0); RES_LOAD(xa, 1, 0);
        RES_STORE(xb, 0, 1); RES_LOAD(xb, 1, 1);
        RES_STORE(xa, 1, 0);
        RES_STORE(xb, 1, 1);
#undef RES_LOAD
#undef RES_STORE
    }
};
struct EpiGeluV {
    static constexpr bool PERM = true, AFTER_DRAIN = false;
    bfu* O; float* part;
    DI void operator()(const pg8::f32x4 (&acc)[2][2][4][2], const pg8::Unit& u, int wr, int wc, int fr, int fq) const {
        const int row0 = u.pm * 256 + wr * 64 + fr, col0 = u.pn * 256 + wc * 32 + 8 * fq;
        const bool isv = u.pn >= 4;
#pragma unroll
        for (int ai = 0; ai < 2; ++ai)
#pragma unroll
            for (int m = 0; m < 4; ++m) { const int row = row0 + ai * 128 + m * 16; bfu* rowp = O + (size_t)row * 2048 + col0; float ss = 0.f;
#pragma unroll
                for (int bj = 0; bj < 2; ++bj) { const pg8::f32x4 v0 = acc[ai][bj][m][0], v1 = acc[ai][bj][m][1];
                    const pg8::f32x2 a = pg8::gelu_pk((pg8::f32x2){v0[0], v0[1]}), b = pg8::gelu_pk((pg8::f32x2){v0[2], v0[3]}), c = pg8::gelu_pk((pg8::f32x2){v1[0], v1[1]}), d = pg8::gelu_pk((pg8::f32x2){v1[2], v1[3]});
                    ss += (a.x * a.x + a.y * a.y) + (b.x * b.x + b.y * b.y) + (c.x * c.x + c.y * c.y) + (d.x * d.x + d.y * d.y);
                    pg8::u32x4 w; w.x = pg8::cvt_pk_bf16(a.x, a.y); w.y = pg8::cvt_pk_bf16(b.x, b.y); w.z = pg8::cvt_pk_bf16(c.x, c.y); w.w = pg8::cvt_pk_bf16(d.x, d.y);
                    *(pg8::u32x4*)(rowp + bj * 128) = w; }
                if (isv) { ss += __shfl_xor(ss, 16); ss += __shfl_xor(ss, 32); if (fq == 0) part[(size_t)row * 16 + (u.pn - 4) * 4 + wc] = ss; }
            }
    }
};
DI float dpp_prev(float x) { return __builtin_bit_cast(float, __builtin_amdgcn_update_dpp(0, __builtin_bit_cast(int, x), 0x111, 0xf, 0xf, true)); }
DI float dpp_next(float x) { return __builtin_bit_cast(float, __builtin_amdgcn_update_dpp(0, __builtin_bit_cast(int, x), 0x101, 0xf, 0xf, true)); }
struct EpiConv {
    static constexpr bool PERM = false, AFTER_DRAIN = false;
    bfu* ACT; bfu* ZB; const float* cw; const float* cb;
    DI void operator()(const pg8::f32x4 (&acc)[2][2][4][2], const pg8::Unit& u, int wr, int wc, int fr, int fq) const {
        const int row0 = u.pm * 256 + wr * 64 + fr;
        const bool edge = (fr < 2) || (fr >= 14); const int eidx = (fr < 2) ? fr : fr - 12;
#pragma unroll
        for (int n = 0; n < 2; ++n) {
            const int jt = wc * 32 + n * 16 + 4 * fq, j = u.pn * 128 + jt;
            const pg8::f32x4 g0 = *(const pg8::f32x4*)(cw + j), g1 = *(const pg8::f32x4*)(cw + 2 * FFN + j), g2 = *(const pg8::f32x4*)(cw + 4 * FFN + j), gb = *(const pg8::f32x4*)(cb + j);
            const pg8::f32x4 u0 = *(const pg8::f32x4*)(cw + FFN + j), u1 = *(const pg8::f32x4*)(cw + 3 * FFN + j), u2 = *(const pg8::f32x4*)(cw + 5 * FFN + j), ub = *(const pg8::f32x4*)(cb + FFN + j);
#pragma unroll
            for (int ai = 0; ai < 2; ++ai)
#pragma unroll
                for (int m = 0; m < 4; ++m) {
                    const int row = row0 + ai * 128 + m * 16;
                    const pg8::f32x4 zg = acc[ai][0][m][n], zu = acc[ai][1][m][n];
                    pg8::f32x4 pg, ng, pu, nu;
#pragma unroll
                    for (int i = 0; i < 4; ++i) { pg[i] = dpp_prev(zg[i]); ng[i] = dpp_next(zg[i]); pu[i] = dpp_prev(zu[i]); nu[i] = dpp_next(zu[i]); }
                    const pg8::f32x4 cg = g0 * pg + g1 * zg + g2 * ng + gb, cu = u0 * pu + u1 * zu + u2 * nu + ub;
                    v2u o; o.x = pk2(silu_f(cg[0]) * cu[0], silu_f(cg[1]) * cu[1]); o.y = pk2(silu_f(cg[2]) * cu[2], silu_f(cg[3]) * cu[3]);
                    *(v2u*)(ACT + (size_t)row * FFN + j) = o;
                    if (edge) { bfu* zb = ZB + ((size_t)(row >> 4) * 4 + eidx) * (2 * FFN) + u.pn * 256 + jt;
                        v2u a; a.x = pk2(zg[0], zg[1]); a.y = pk2(zg[2], zg[3]); *(v2u*)zb = a;
                        v2u b; b.x = pk2(zu[0], zu[1]); b.y = pk2(zu[2], zu[3]); *(v2u*)(zb + 128) = b; }
                }
        }
    }
};
struct RowSched {
    pg8::StaticOrder so; int skip;
    DI void init(int N, int G, int c, int skip_ctx) { so.init(skip_ctx ? NBATCH * SEQ : MROWS, N, G, c); skip = skip_ctx; }
    DI bool next(int i, pg8::Unit& u) const { if (!so.next(i, u)) return false; if (skip) u.pm = (u.pm >> 6) * 65 + 1 + (u.pm & 63); return true; }
    DI void a_ready(const pg8::Unit&) const {}
    DI void done(const pg8::Unit&) const {}
};

template <int NB  > DI void p_ctx_resid(const bfu* A, int K, const bfu* Wt, const float* xsrc, float* xdst, const float* gate, LAS unsigned char* lds, int bx, int G) {
    PHASE_IDS();
    const int r32 = lane & 31, hi = lane >> 5;
    LAS float* part = (LAS float*)lds;
    const int spw = K / 128;
    for (int blk = bx; blk < 256; blk += G) {
        const int rb = blk >> 4, cb = blk & 15, cr0 = rb * 32, c0 = cb * 64;
        const int cr = cr0 + r32, grow = (cr >> 8) * SEGR + (cr & 255);
        const bfu* ap = A + (size_t)grow * K + (size_t)wave * spw * 16 + 8 * hi;
        const bfu* bp0 = Wt + (size_t)(c0 + r32) * K + (size_t)wave * spw * 16 + 8 * hi;
        const bfu* bp1 = bp0 + (size_t)32 * K;
        f32x16 acc0 = f32x16{}, acc1 = f32x16{};
#pragma unroll 1
        for (int s0 = 0; s0 < spw; s0 += NB) {
            bf16x8 af[NB], b0[NB], b1[NB];
#pragma unroll
            for (int q = 0; q < NB; ++q) { af[q] = *(const bf16x8*)(ap + 16 * (s0 + q)); b0[q] = *(const bf16x8*)(bp0 + 16 * (s0 + q)); b1[q] = *(const bf16x8*)(bp1 + 16 * (s0 + q)); }
#pragma unroll
            for (int q = 0; q < NB; ++q) { acc0 = __builtin_amdgcn_mfma_f32_32x32x16_bf16(af[q], b0[q], acc0, 0, 0, 0); acc1 = __builtin_amdgcn_mfma_f32_32x32x16_bf16(af[q], b1[q], acc1, 0, 0, 0); }
        }
        LAS float* pw = part + ((wave * 2) * 64 + lane) * 16;
#pragma unroll
        for (int v = 0; v < 16; ++v) { pw[v] = acc0[v]; pw[64 * 16 + v] = acc1[v]; }
        __syncthreads();
        { const int e = tid * 4, j = e >> 10, ln = (e >> 4) & 63, v0 = e & 15;
          f32x4 s = *(const LAS f32x4*)(part + e);
#pragma unroll
          for (int w = 1; w < 8; ++w) s = s + *(const LAS f32x4*)(part + w * 2048 + e);
          const int col = c0 + 32 * j + (ln & 31); const float gt = gate[col];
#pragma unroll
          for (int q = 0; q < 4; ++q) { const int v = v0 + q, row = cr0 + (v & 3) + 8 * (v >> 2) + 4 * (ln >> 5);
              const size_t o = (size_t)row * DM + col; xdst[o] = xsrc[o] + gt * s[q]; } }
        __syncthreads();
    }
}

DI void transpose_item(const float* W, int K, int N, bfu* WT, int mode, LAS float* scr, int item, int lane) {
    const int nblk = N / 32, kb = item / nblk, nb = item % nblk, k0 = 64 * kb, n0 = 32 * nb;
    int orow0 = n0;
    if (mode == 1) { const int isu = n0 >= FFN, j0 = isu ? n0 - FFN : n0; orow0 = (j0 >> 7) * 256 + isu * 128 + (j0 & 127); }
#pragma unroll 8
    for (int i = 0; i < 32; ++i) { const int kk = 2 * i + (lane >> 5); scr[kk * 33 + (lane & 31)] = W[(size_t)(k0 + kk) * N + n0 + (lane & 31)]; }
    LDS_WAIT(); asm volatile("" ::: "memory");
    const int c = lane & 7;
#pragma unroll
    for (int j = 0; j < 4; ++j) { const int n = (lane >> 3) + 8 * j; const LAS float* s = scr + (8 * c) * 33 + n;
        v4u o; o.x = pk2(s[0 * 33], s[1 * 33]); o.y = pk2(s[2 * 33], s[3 * 33]); o.z = pk2(s[4 * 33], s[5 * 33]); o.w = pk2(s[6 * 33], s[7 * 33]);
        *(v4u*)(WT + (size_t)(orow0 + n) * K + k0 + 8 * c) = o; }
    LDS_WAIT(); asm volatile("" ::: "memory");
}
DI void convert_weights(const float* W, int K, int N, bfu* WT, int mode, LAS unsigned char* lds, int bx, int G) {
    PHASE_IDS();
    LAS float* scr = (LAS float*)(lds + wave * 16384);
    const int nitems = (K / 64) * (N / 32);
    for (int it = gw; it < nitems; it += ngw) transpose_item(W, K, N, WT, mode, scr, it, lane);
}

DI void p_mods(const float* c, const float* cctx, const float* ada_w, const float* ada_b, float* mods, LAS float* sl, int bx, int G) {
    PHASE_IDS();
    LAS float* part = sl + 3 * DM;
    for (int i = tid; i < 3 * DM; i += NTHR) { const float v = (i < 2 * DM) ? c[i] : cctx[i - 2 * DM]; sl[i] = silu_f(v); }
    __syncthreads();
    for (int it = bx; it < 4 * 96; it += G) {
        const int l = it / 96, jb = it % 96, j = jb * 64 + lane, k0 = wave * 128;
        const float* wp = ada_w + ((size_t)l * DM + k0) * NMOD + j;
        float a0 = 0.f, a1 = 0.f, a2 = 0.f;
#pragma unroll 8
        for (int k = 0; k < 128; ++k) { const float w = wp[(size_t)k * NMOD]; a0 += sl[k0 + k] * w; a1 += sl[DM + k0 + k] * w; a2 += sl[2 * DM + k0 + k] * w; }
        part[(wave * 3 + 0) * 64 + lane] = a0; part[(wave * 3 + 1) * 64 + lane] = a1; part[(wave * 3 + 2) * 64 + lane] = a2;
        __syncthreads();
        if (tid < 192) { const int wh = tid >> 6; float s = ada_b[l * NMOD + j];
#pragma unroll
            for (int q = 0; q < 8; ++q) s += part[(q * 3 + wh) * 64 + lane];
            mods[((size_t)l * 3 + wh) * NMOD + j] = s; }
        __syncthreads();
    }
}

DI float* xrow(float* xlat, float* xctx, int r, int& which, bool& isctx) {
    const int b = r / SEGR, p = r % SEGR; isctx = p < CTXL; which = isctx ? 2 : b;
    return isctx ? xctx + (size_t)(b * CTXL + p) * DM : xlat + ((size_t)b * SEQ + (p - CTXL)) * DM;
}

template <bool COPY>
DI void p_norm(const float* slat, const float* sctx, float* dlat, float* dctx, const float* w, const float* mods_l, int o_sh, int o_sc, bfu* H, bool do_ctx, int bx, int G) {
    PHASE_IDS();
    int cur = -1; f32x4 av[4], bv[4];
#pragma unroll
    for (int j = 0; j < 4; ++j) { av[j] = (f32x4){0.f, 0.f, 0.f, 0.f}; bv[j] = av[j]; }
    for (int r = gw; r < MROWS; r += ngw) {
        int which; bool isctx; const float* xr = xrow((float*)slat, (float*)sctx, r, which, isctx);
        if (isctx && !do_ctx) continue;
        const f32x4* x4 = (const f32x4*)xr + lane;
        f32x4 v[4]; float s = 0.f;
#pragma unroll
        for (int j = 0; j < 4; ++j) v[j] = x4[64 * j];
        if (which != cur) { cur = which; const float* md = mods_l + which * NMOD;
#pragma unroll
            for (int j = 0; j < 4; ++j) { const int c = 4 * (lane + 64 * j);
                const f32x4 wv = *(const f32x4*)(w + c), sc = *(const f32x4*)(md + o_sc + c); av[j] = wv * (sc + 1.f); bv[j] = *(const f32x4*)(md + o_sh + c); } }
#pragma unroll
        for (int j = 0; j < 4; ++j) s += (v[j].x * v[j].x + v[j].y * v[j].y) + (v[j].z * v[j].z + v[j].w * v[j].w);
        const float rstd = __builtin_amdgcn_rsqf(wave_sum(s) * (1.f / DM) + EPS);
        if (COPY) { int w2; bool c2; f32x4* d4 = (f32x4*)xrow(dlat, dctx, r, w2, c2) + lane;
#pragma unroll
            for (int j = 0; j < 4; ++j) d4[64 * j] = v[j]; }
        v2u* o8 = (v2u*)(H + (size_t)r * DM) + lane;
#pragma unroll
        for (int j = 0; j < 4; ++j) { const f32x4 y = v[j] * rstd * av[j] + bv[j];
            v2u o; o.x = pk2(y.x, y.y); o.y = pk2(y.z, y.w); o8[64 * j] = o; }
    }
}
DI void p_final(float* xlat, const float* w, int bx, int G) {
    PHASE_IDS();
    f32x4 wv4[4];
#pragma unroll
    for (int j = 0; j < 4; ++j) wv4[j] = *(const f32x4*)(w + 4 * (lane + 64 * j));
    for (int r = gw; r < NBATCH * SEQ; r += ngw) {
        f32x4* x4 = (f32x4*)(xlat + (size_t)r * DM) + lane;
        f32x4 v[4]; float s = 0.f;
#pragma unroll
        for (int j = 0; j < 4; ++j) { v[j] = x4[64 * j]; s += (v[j].x * v[j].x + v[j].y * v[j].y) + (v[j].z * v[j].z + v[j].w * v[j].w); }
        const float rstd = 1.f / sqrtf(wave_sum(s) * (1.f / DM) + EPS);
#pragma unroll
        for (int j = 0; j < 4; ++j) x4[64 * j] = v[j] * rstd * wv4[j];
    }
}

DI void p_qkvpost(bfu* QKV, const float* qnorm, const float* knorm, int bx, int G) {
    PHASE_IDS();
    const int i = lane & 31, hh = lane >> 5, fi = i & 15;
    const float inv = exp2f(-(float)fi * (13.287712379549449f / 16.f));
    const float C2 = 0.125f * 1.4426950408889634f;
    const float qn0 = qnorm[2 * i], qn1 = qnorm[2 * i + 1], kn0 = knorm[2 * i], kn1 = knorm[2 * i + 1];
    for (int r = gw; r < MROWS; r += ngw) {
        const int p = r % SEGR; const bool isctx = p < CTXL; const int t = p - CTXL;
        float cs = 1.f, sn = 0.f;
        if (!isctx) { const float pos = (float)((i < 16) ? (t >> 6) : (t & 63)); const float ang = pos * inv;
            const float k = rintf(ang * 0.15915494309189535f); float rr = fmaf(-k, 6.2831854820251465f, ang); rr = fmaf(-k, -1.7484555e-7f, rr);
            cs = cosf(rr); sn = sinf(rr); }
        bfu* row = QKV + (size_t)r * NQKV;
        unsigned uu[13];
#pragma unroll
        for (int it = 0; it < 13; ++it) { const int hs = 2 * it + hh;
            const int col0 = (hs < 16) ? hs * 64 : (hs < 24 ? 1536 + (hs - 16) * 64 : 2048 + (hs - 24) * 64);
            uu[it] = *((const unsigned*)(row + col0) + i); }
#pragma unroll
        for (int it = 0; it < 13; ++it) {
            const int hs = 2 * it + hh;
            const int col0 = (hs < 16) ? hs * 64 : (hs < 24 ? 1536 + (hs - 16) * 64 : 2048 + (hs - 24) * 64);
            float x0 = bflo(uu[it]), x1 = bfhi(uu[it]);
            if (it >= 8) { const float ss = half_sum(x0 * x0 + x1 * x1); const float rstd = 1.f / sqrtf(ss * (1.f / 64.f) + EPS);
                x0 *= rstd * ((it < 12) ? qn0 : kn0); x1 *= rstd * ((it < 12) ? qn1 : kn1); }
            float y0 = x0 * cs - x1 * sn, y1 = x0 * sn + x1 * cs;
            if (it < 4 || (it >= 8 && it < 12)) { y0 *= C2; y1 *= C2; }
            *((unsigned*)(row + col0) + i) = pk2(y0, y1);
        }
    }
}

DI void attn_pair(const bfu* QKV, bfu* AOR, bfu* AO, int b, int hd, size_t qrow_off, int NT, float lam, const float* subln, float omli, char* lds) {
    using abf = attn_body::bf16;
    const size_t rb = (size_t)b * SEGR, rq = rb + qrow_off;
    const bfu* V = QKV + rb * NQKV + 1024 + hd * 128; bfu* O1 = AOR + rq * NAO + hd * 256;
    attn_body::attn_unit128<8, 0>((const abf*)(QKV + rq * NQKV + hd * 64), (const abf*)(QKV + rb * NQKV + 512 + hd * 64), (const abf*)V, (abf*)O1, NT, lds, nullptr, nullptr, 0.f, nullptr, 0.f);
    attn_body::attn_unit128<8, 1>((const abf*)(QKV + rq * NQKV + 256 + hd * 64), (const abf*)(QKV + rb * NQKV + 768 + hd * 64), (const abf*)V, (abf*)O1, NT, lds, (const abf*)O1, (abf*)(AO + rq * DM + hd * 128), lam, subln, omli);
}
DI void attn_gqa(const bfu* QKV, bfu* AO, int b, int hq, size_t qrow_off, int NT, char* lds) {
    using abf = attn_body::bf16;
    const size_t rb = (size_t)b * SEGR, rq = rb + qrow_off; const int g = hq >> 2;
    attn_body::attn_unit<8>((const abf*)(QKV + rq * NQKV + 1536 + hq * 64), (const abf*)(QKV + rb * NQKV + 2048 + g * 64), (const abf*)(QKV + rb * NQKV + 2176 + g * 64), (abf*)(AO + rq * DM + 512 + hq * 64), DM, NT, lds);
}
DI void p_attn(const bfu* QKV, bfu* AOR, bfu* AO, const float* lq1, const float* lk1, const float* lq2, const float* lk2, const float* subln, float lam_init, bool ctx_out, char* lds, int bx, int G, int vcu, int xmap) {
    PHASE_IDS();
    const float lam = __expf(wave_sum(lq1[lane] * lk1[lane])) - __expf(wave_sum(lq2[lane] * lk2[lane])) + lam_init, omli = 1.f - lam_init;
    const int npair = 8 * 64 + (ctx_out ? 8 : 0), ngqa = 16 * 64 + (ctx_out ? 16 : 0);
    for (int i = 0;; ++i) {
        int u;
        if (xmap) { if (i >= 2) { u = 512 + (i - 2) * G + bx; if (u < 512 || i > 2 || !(u < npair)) break; } else u = (vcu >> 5) * 64 + i * 32 + (vcu & 31); }
        else { u = i * G + bx; if (u >= npair) break; }
        if (u < 512) attn_pair(QKV, AOR, AO, (u >> 6) >> 2, (u >> 6) & 3, CTXL + (size_t)(u & 63) * 256, SEGR / 64, lam, subln, omli, lds);
        else attn_pair(QKV, AOR, AO, (u - 512) >> 2, (u - 512) & 3, 0, CTXL / 64, lam, subln, omli, lds);
    }
    for (int i = 0;; ++i) {
        int u;
        if (xmap) { if (i >= 4) { u = 1024 + (i - 4) * G + bx; if (i > 4 || !(u < ngqa)) break; } else u = (2 * (vcu >> 5) + (i >> 1)) * 64 + (i & 1) * 32 + (vcu & 31); }
        else { u = i * G + bx; if (u >= ngqa) break; }
        if (u < 1024) attn_gqa(QKV, AO, (u >> 6) >> 3, (u >> 6) & 7, CTXL + (size_t)(u & 63) * 256, SEGR / 64, lds);
        else attn_gqa(QKV, AO, (u - 1024) >> 3, (u - 1024) & 7, 0, CTXL / 64, lds);
    }
}

DI void p_sgu_mix(const bfu* UV, const float* part, const float* vnorm, const bfu* Wsb, const float* bs, bfu* So, bool do_ctx, LAS unsigned char* lds, int bx, int G) {
    PHASE_IDS();
    const int w = wave, r32 = lane & 31, hi = lane >> 5;
    constexpr int VS = 264;
    LAS bfu* Vr = (LAS bfu*)lds; LAS float* rsl = (LAS float*)(lds + 69632);
    const int c8 = (tid & 31) * 8;
    int gcur = -1; bf16x8 afr[4][8];
    for (int it = bx; it < (MROWS / 128) * 4; it += G) {
        const int n = it >> 2, g = it & 3, R0 = n * 128, c0 = g * 256;
        if (!do_ctx && (R0 % SEGR) < CTXL) continue;
        const f32x4 n0 = *(const f32x4*)(vnorm + c0 + c8), n1 = *(const f32x4*)(vnorm + c0 + c8 + 4);
        v4u vin[8]; float rsv[8];
#pragma unroll
        for (int k = 0; k < 8; ++k) { const int q = (tid >> 5) + 16 * k; vin[k] = *(const v4u*)(UV + (size_t)(R0 + q) * 2048 + 1024 + c0 + c8); }
        if (tid < 128) { const f32x4* pp = (const f32x4*)(part + (size_t)(R0 + tid) * 16); const f32x4 p0 = pp[0], p1 = pp[1], p2 = pp[2], p3 = pp[3];
            float s = p0.x; s += p0.y; s += p0.z; s += p0.w; s += p1.x; s += p1.y; s += p1.z; s += p1.w; s += p2.x; s += p2.y; s += p2.z; s += p2.w; s += p3.x; s += p3.y; s += p3.z; s += p3.w;
            rsl[tid] = 1.f / sqrtf(s * (1.f / DM) + EPS); }
        __syncthreads();
#pragma unroll
        for (int k = 0; k < 8; ++k) rsv[k] = rsl[(tid >> 5) + 16 * k];
        if (g != gcur) { gcur = g; const bfu* Wg = Wsb + (size_t)g * 16384;
#pragma unroll
            for (int pb = 0; pb < 4; ++pb)
#pragma unroll
                for (int ks = 0; ks < 8; ++ks) afr[pb][ks] = *(const bf16x8*)(Wg + (32 * pb + r32) * 128 + 16 * ks + 8 * hi); }
#pragma unroll
        for (int k = 0; k < 8; ++k) { const int q = (tid >> 5) + 16 * k; const v4u u = vin[k]; const float rs = rsv[k];
            v4u o; o.x = pk2(bflo(u.x) * rs * n0.x, bfhi(u.x) * rs * n0.y); o.y = pk2(bflo(u.y) * rs * n0.z, bfhi(u.y) * rs * n0.w);
            o.z = pk2(bflo(u.z) * rs * n1.x, bfhi(u.z) * rs * n1.y); o.w = pk2(bflo(u.w) * rs * n1.z, bfhi(u.w) * rs * n1.w);
            *(LAS v4u*)(Vr + q * VS + c8) = o; }
        __syncthreads();
        f32x16 acc[4];
#pragma unroll
        for (int pb = 0; pb < 4; ++pb) acc[pb] = f32x16{};
        const int cl = 32 * w + r32;
#pragma unroll
        for (int ks = 0; ks < 8; ++ks) {
            const LAS bfu* vp = Vr + (16 * ks + 8 * hi) * VS + cl;
            v4u bw; bw.x = (unsigned)vp[0] | ((unsigned)vp[VS] << 16); bw.y = (unsigned)vp[2 * VS] | ((unsigned)vp[3 * VS] << 16);
            bw.z = (unsigned)vp[4 * VS] | ((unsigned)vp[5 * VS] << 16); bw.w = (unsigned)vp[6 * VS] | ((unsigned)vp[7 * VS] << 16);
            const bf16x8 bfr = __builtin_bit_cast(bf16x8, bw);
#pragma unroll
            for (int pb = 0; pb < 4; ++pb) acc[pb] = __builtin_amdgcn_mfma_f32_32x32x16_bf16(afr[pb][ks], bfr, acc[pb], 0, 0, 0);
        }
        const int c = c0 + cl;
#pragma unroll
        for (int pb = 0; pb < 4; ++pb) {
            unsigned short ur[16]; float bb[16];
#pragma unroll
            for (int v = 0; v < 16; ++v) { const int p = 32 * pb + (v & 3) + 8 * (v >> 2) + 4 * hi; ur[v] = UV[(size_t)(R0 + p) * 2048 + c]; bb[v] = bs[g * 128 + p]; }
#pragma unroll
            for (int v = 0; v < 16; ++v) { const int p = 32 * pb + (v & 3) + 8 * (v >> 2) + 4 * hi;
                const float uu = __builtin_bit_cast(float, (unsigned)ur[v] << 16);
                So[(size_t)(R0 + p) * DM + c] = (bfu)f2bf(uu * (acc[pb][v] + bb[v])); }
        }
        __syncthreads();
    }
}

DI void p_convfix(const bfu* ZB, bfu* ACT, const float* cw, const float* cb, bool do_ctx, int bx, int G) {
    PHASE_IDS();
    constexpr int CPR = FFN / 8;
    const int nitems = (MROWS / 16) * CPR;
    for (int it = bx * NTHR + tid; it < nitems; it += G * NTHR) {
        const int k = it / CPR, ch = it % CPR, j = ch * 8, pn = j >> 7, jt = j & 127;
        const int r0 = k * 16, p0 = r0 % SEGR;
        if (!do_ctx && p0 < CTXL) continue;
        const bool first = (p0 == 0) || (p0 == CTXL), last = (p0 + 16 == CTXL) || (p0 + 16 == SEGR);
        const bfu* zb = ZB + (size_t)k * 4 * (2 * FFN) + pn * 256 + jt;
        const v4u zero = (v4u){0u, 0u, 0u, 0u};
        v4u zg[6], zu[6];
        if (first) { zg[0] = zero; zu[0] = zero; } else { zg[0] = *(const v4u*)(zb - (2 * FFN)); zu[0] = *(const v4u*)(zb - (2 * FFN) + 128); }
#pragma unroll
        for (int q = 0; q < 4; ++q) { zg[1 + q] = *(const v4u*)(zb + (size_t)q * (2 * FFN)); zu[1 + q] = *(const v4u*)(zb + (size_t)q * (2 * FFN) + 128); }
        if (last) { zg[5] = zero; zu[5] = zero; } else { zg[5] = *(const v4u*)(zb + (size_t)4 * (2 * FFN)); zu[5] = *(const v4u*)(zb + (size_t)4 * (2 * FFN) + 128); }
        float wg[3][8], wu[3][8], bg[8], bu[8];
#pragma unroll
        for (int d = 0; d < 3; ++d) { const f32x4 a = *(const f32x4*)(cw + d * 2 * FFN + j), b = *(const f32x4*)(cw + d * 2 * FFN + j + 4), c = *(const f32x4*)(cw + d * 2 * FFN + FFN + j), e = *(const f32x4*)(cw + d * 2 * FFN + FFN + j + 4);
            wg[d][0] = a.x; wg[d][1] = a.y; wg[d][2] = a.z; wg[d][3] = a.w; wg[d][4] = b.x; wg[d][5] = b.y; wg[d][6] = b.z; wg[d][7] = b.w;
            wu[d][0] = c.x; wu[d][1] = c.y; wu[d][2] = c.z; wu[d][3] = c.w; wu[d][4] = e.x; wu[d][5] = e.y; wu[d][6] = e.z; wu[d][7] = e.w; }
        { const f32x4 a = *(const f32x4*)(cb + j), b = *(const f32x4*)(cb + j + 4), c = *(const f32x4*)(cb + FFN + j), e = *(const f32x4*)(cb + FFN + j + 4);
            bg[0] = a.x; bg[1] = a.y; bg[2] = a.z; bg[3] = a.w; bg[4] = b.x; bg[5] = b.y; bg[6] = b.z; bg[7] = b.w;
            bu[0] = c.x; bu[1] = c.y; bu[2] = c.z; bu[3] = c.w; bu[4] = e.x; bu[5] = e.y; bu[6] = e.z; bu[7] = e.w; }
#pragma unroll
        for (int s = 0; s < 2; ++s) {
            const v4u gp = zg[3 * s], gc = zg[3 * s + 1], gn = zg[3 * s + 2], up = zu[3 * s], uc = zu[3 * s + 1], un = zu[3 * s + 2];
            float o[8];
#define CV(kk, P, LOHI) { const float zgv = wg[0][kk] * LOHI(gp.P) + wg[1][kk] * LOHI(gc.P) + wg[2][kk] * LOHI(gn.P) + bg[kk]; \
                          const float zuv = wu[0][kk] * LOHI(up.P) + wu[1][kk] * LOHI(uc.P) + wu[2][kk] * LOHI(un.P) + bu[kk]; o[kk] = silu_f(zgv) * zuv; }
            CV(0, x, bflo) CV(1, x, bfhi) CV(2, y, bflo) CV(3, y, bfhi) CV(4, z, bflo) CV(5, z, bfhi) CV(6, w, bflo) CV(7, w, bfhi)
#undef CV
            v4u ov; ov.x = pk2(o[0], o[1]); ov.y = pk2(o[2], o[3]); ov.z = pk2(o[4], o[5]); ov.w = pk2(o[6], o[7]);
            *(v4u*)(ACT + (size_t)(r0 + 15 * s) * FFN + j) = ov;
        }
    }
}

struct Args { const float* in[27]; float* out; unsigned char* ws; };
enum { I_X = 0, I_C, I_CTX, I_CCTX, I_ADAW, I_ADAB, I_MIXN, I_FFNN, I_FINN, I_AWIN, I_AWOUT, I_LQ1, I_LK1, I_LQ2, I_LK2, I_SUBLN, I_QN, I_KN,
       I_SWIN, I_SVN, I_SWS, I_SBS, I_SWOUT, I_FUP, I_FCW, I_FCB, I_FDN };

#ifndef PROBE_ATTN
#define PROBE_ATTN 1
#endif
#ifndef PROBE_SYNC
#define PROBE_SYNC 1
#endif
#ifndef PROBE_GEMM
#define PROBE_GEMM 1
#endif
#ifndef PROBE_MISC
#define PROBE_MISC 1
#endif
#ifndef PROBE_CONV
#define PROBE_CONV 1
#endif
#ifndef PROBE_ELT
#define PROBE_ELT 1
#endif
#define GSYNC() do { for (int rs_ = 0; rs_ < PROBE_SYNC; ++rs_) xcd_barrier(xbar); } while (0)
#define ELT(x) do { for (int re_ = 0; re_ < PROBE_ELT; ++re_) { x; } } while (0)
__global__ void __launch_bounds__(NTHR, 2) fwd_megakernel(Args a) {
    extern __shared__ __attribute__((aligned(16))) unsigned char lds_raw[];
    cg::grid_group grid = cg::this_grid();
    LAS unsigned char* lds = (LAS unsigned char*)lds_raw;
    const int G = gridDim.x, bx = blockIdx.x;
    unsigned char* ws = a.ws;
    float* mods = (float*)(ws + WS_MODS); float* ctxx = (float*)(ws + WS_CTXX); float* rstd = (float*)(ws + WS_RSTD);
    bfu* wmixa = (bfu*)(ws + WS_WMIXA); bfu* wmixb = (bfu*)(ws + WS_WMIXB); bfu* wmixs = (bfu*)(ws + WS_WMIXS);
    bfu* wup = (bfu*)(ws + WS_WUP); bfu* wdn = (bfu*)(ws + WS_WDN);
    bfu* H = (bfu*)(ws + WS_H); bfu* QKV = (bfu*)(ws + WS_QKV); bfu* AOR = (bfu*)(ws + WS_AORAW); bfu* AO = (bfu*)(ws + WS_AO);
    bfu* UV = (bfu*)(ws + WS_UV); bfu* SB = (bfu*)(ws + WS_S); bfu* ZB = (bfu*)(ws + WS_ZB); bfu* ACT = (bfu*)(ws + WS_ACT);
    float* xlat = a.out;
    volatile LAS unsigned* bst = (volatile LAS unsigned*)(lds + LDS_BYTES - 64);
    if (threadIdx.x < 2) bst[threadIdx.x] = 0u;
    __syncthreads();
    const XcdBarrier xbar = xcd_barrier_post((unsigned*)(ws + WS_BAR), bst);
    if (threadIdx.x == 0) { const unsigned xc = xb_xcc_id() & 7u; bst[2] = xc; bst[3] = atomicAdd((unsigned*)(ws + WS_BAR) + 3500 + xc, 1u); }

    for (int rc_ = 0; rc_ < PROBE_CONV; ++rc_) p_mods(a.in[I_C], a.in[I_CCTX], a.in[I_ADAW], a.in[I_ADAB], mods, (LAS float*)lds, bx, G);
    for (int rc_ = 0; rc_ < PROBE_CONV; ++rc_) convert_weights(a.in[I_AWIN], DM, NQKV, wmixa, 0, lds, bx, G);
    for (int rc_ = 0; rc_ < PROBE_CONV; ++rc_) convert_weights(a.in[I_AWOUT], DM, DM, wmixb, 0, lds, bx, G);
    if (gridDim.x == 0x7fffffffu) grid.sync();
    GSYNC();
    int cid = bx, vcu = bx, xmap = 0;
    { bool even = (G % 8 == 0);
      for (int j = 0; j < 8; ++j) even = even && (__hip_atomic_load((unsigned*)(ws + WS_BAR) + 3500 + j, __ATOMIC_RELAXED, __HIP_MEMORY_SCOPE_AGENT) == (unsigned)(G / 8));
      if (even) { const int xc = (int)bst[2], rk = (int)bst[3]; cid = rk * 8 + xc; vcu = xc * (G / 8) + rk; xmap = (G == 256); }
      cid = __builtin_amdgcn_readfirstlane(cid); vcu = __builtin_amdgcn_readfirstlane(vcu); xmap = __builtin_amdgcn_readfirstlane(xmap); }

#pragma unroll 1
    for (int l = 0; l < 4; ++l) {
        int bxl = cid, Gl = G, vcul = vcu; asm volatile("" : "+s"(bxl), "+s"(Gl), "+s"(vcul));
        const int li = l >> 1; const bool is_attn = (l & 1) == 0; const bool upd_ctx = l < 2;
        const bool ctx_in = is_attn || upd_ctx;
        const float* mods_l = mods + (size_t)l * 3 * NMOD;
        const float lam_init = (l == 0) ? 0.2f : 0.47071302f;

        if (l == 0) p_norm<false>(a.in[I_X], a.in[I_CTX], nullptr, nullptr, a.in[I_MIXN], mods_l, 0, DM, H, true, bxl, Gl);
        else ELT(p_norm<false>(xlat, ctxx, nullptr, nullptr, a.in[I_MIXN] + l * DM, mods_l, 0, DM, H, ctx_in, bxl, Gl));
        for (int rc_ = 0; rc_ < PROBE_CONV; ++rc_) convert_weights(a.in[I_FUP] + (size_t)l * DM * 2 * FFN, DM, 2 * FFN, wup, 1, lds, bxl, Gl);
        for (int rc_ = 0; rc_ < PROBE_CONV; ++rc_) convert_weights(a.in[I_FDN] + (size_t)l * FFN * DM, FFN, DM, wdn, 0, lds, bxl, Gl);
        GSYNC();

        if (is_attn) {
            { pg8::Gemm g{H, wmixa, MROWS, NQKV, DM}; RowSched S; S.init(NQKV, Gl, bxl, 0);
              pg8::EpiBf16<0> E{QKV, NQKV, nullptr, 0, 0, 1.f};
              for (int rg_ = 0; rg_ < PROBE_GEMM; ++rg_) pg8::gemm_phase<pg8::EpiBf16<0>, RowSched, true, true>(lds, g, S, E); }
            GSYNC();
            p_qkvpost(QKV, a.in[I_QN] + li * 64, a.in[I_KN] + li * 64, bxl, Gl);
#ifdef PROBE_POST
            for (int rp_ = 0; rp_ < PROBE_POST; ++rp_) p_qkvpost(AOR, a.in[I_QN] + li * 64, a.in[I_KN] + li * 64, bxl, Gl);
#endif
            GSYNC();
            for (int rep_ = 0; rep_ < PROBE_ATTN; ++rep_) p_attn(QKV, AOR, AO, a.in[I_LQ1] + li * 64, a.in[I_LK1] + li * 64, a.in[I_LQ2] + li * 64, a.in[I_LK2] + li * 64, a.in[I_SUBLN] + li * 128, lam_init, upd_ctx, (char*)lds_raw, bxl, Gl, vcul, xmap);
            GSYNC();
        } else {
            { pg8::Gemm g{H, wmixa, MROWS, 2 * DM, DM}; RowSched S; S.init(2 * DM, Gl, bxl, !upd_ctx);
              EpiGeluV E{UV, rstd};
              pg8::gemm_phase<EpiGeluV, RowSched, true, true>(lds, g, S, E); }
            GSYNC();
            for (int rm_ = 0; rm_ < PROBE_MISC; ++rm_) p_sgu_mix(UV, rstd, a.in[I_SVN] + li * DM, wmixs, a.in[I_SBS] + li * 512, SB, upd_ctx, lds, bxl, Gl);
            GSYNC();
        }
        if (upd_ctx) p_ctx_resid<8>(is_attn ? AO : SB, DM, wmixb, l == 0 ? a.in[I_CTX] : ctxx, ctxx, mods_l + 2 * NMOD + 2 * DM, lds, bxl, Gl);
        { pg8::Gemm g{is_attn ? AO : SB, wmixb, MROWS, DM, DM}; RowSched S; S.init(DM, Gl, bxl, 1);
#ifdef PROBE_RES
          { EpiResid E2{xlat, ctxx, (float*)(ws + WS_BIG) + 512 * 1024, (float*)(ws + WS_BIG), mods_l + 2 * DM}; pg8::gemm_phase<EpiResid, RowSched, true, true>(lds, g, S, E2); }
#endif
          EpiResid E{l == 0 ? a.in[I_X] : xlat, l == 0 ? a.in[I_CTX] : ctxx, xlat, ctxx, mods_l + 2 * DM};
          pg8::gemm_phase<EpiResid, RowSched, true, true>(lds, g, S, E); }
        GSYNC();

        ELT(p_norm<false>(xlat, ctxx, nullptr, nullptr, a.in[I_FFNN] + l * DM, mods_l, 3 * DM, 4 * DM, H, upd_ctx, bxl, Gl));
        if (l < 3) {
            const int nl = l + 1, ni = nl >> 1;
            if ((nl & 1) == 0) {
                for (int rc_ = 0; rc_ < PROBE_CONV; ++rc_) convert_weights(a.in[I_AWIN] + (size_t)ni * DM * NQKV, DM, NQKV, wmixa, 0, lds, bxl, Gl);
                for (int rc_ = 0; rc_ < PROBE_CONV; ++rc_) convert_weights(a.in[I_AWOUT] + (size_t)ni * DM * DM, DM, DM, wmixb, 0, lds, bxl, Gl);
            } else {
                for (int rc_ = 0; rc_ < PROBE_CONV; ++rc_) convert_weights(a.in[I_SWIN] + (size_t)ni * DM * 2 * DM, DM, 2 * DM, wmixa, 0, lds, bxl, Gl);
                for (int rc_ = 0; rc_ < PROBE_CONV; ++rc_) convert_weights(a.in[I_SWOUT] + (size_t)ni * DM * DM, DM, DM, wmixb, 0, lds, bxl, Gl);
                const float* wsrc = a.in[I_SWS] + (size_t)ni * 65536;
                for (int e = bxl * NTHR + opaque_tid(); e < 32768; e += Gl * NTHR) ((unsigned*)wmixs)[e] = pk2(wsrc[2 * e], wsrc[2 * e + 1]);
            }
        }
        GSYNC();

        { pg8::Gemm g{H, wup, MROWS, 2 * FFN, DM}; RowSched S; S.init(2 * FFN, Gl, bxl, !upd_ctx);
          EpiConv E{ACT, ZB, a.in[I_FCW] + (size_t)l * 3 * 2 * FFN, a.in[I_FCB] + (size_t)l * 2 * FFN};
          pg8::gemm_phase<EpiConv, RowSched, true, true>(lds, g, S, E); }
        GSYNC();
        p_convfix(ZB, ACT, a.in[I_FCW] + (size_t)l * 3 * 2 * FFN, a.in[I_FCB] + (size_t)l * 2 * FFN, upd_ctx, bxl, Gl);
        GSYNC();
        if (upd_ctx) p_ctx_resid<11>(ACT, FFN, wdn, ctxx, ctxx, mods_l + 2 * NMOD + 5 * DM, lds, bxl, Gl);
        { pg8::Gemm g{ACT, wdn, MROWS, DM, FFN}; RowSched S; S.init(DM, Gl, bxl, 1);
#ifdef PROBE_RES
          { EpiResid E2{xlat, ctxx, (float*)(ws + WS_BIG) + 512 * 1024, (float*)(ws + WS_BIG), mods_l + 5 * DM}; pg8::gemm_phase<EpiResid, RowSched, true, true>(lds, g, S, E2); }
#endif
          EpiResid E{xlat, ctxx, xlat, ctxx, mods_l + 5 * DM};
          pg8::gemm_phase<EpiResid, RowSched, true, true>(lds, g, S, E); }
        GSYNC();
    }
    p_final(xlat, a.in[I_FINN], cid, G);
}

extern "C" void kernel_launch(void* const* d_in, const int* in_sizes, int n_in, void* d_out, int out_size, void* d_ws, size_t ws_size, hipStream_t stream) {
    static int grid = 0;
    if (grid == 0) {
        if (n_in != 27 || ws_size < WS_END) { fprintf(stderr, "kernel_launch: unexpected n_in %d / ws %zu\n", n_in, ws_size); grid = -1; return; }
        int dev = 0, cus = 0, per_cu = 0;
        (void)hipGetDevice(&dev);
        (void)hipDeviceGetAttribute(&cus, hipDeviceAttributeMultiprocessorCount, dev);
        if (hipFuncSetAttribute((const void*)fwd_megakernel, hipFuncAttributeMaxDynamicSharedMemorySize, LDS_BYTES) != hipSuccess) { fprintf(stderr, "kernel_launch: hipFuncSetAttribute failed\n"); grid = -1; return; }
        if (hipOccupancyMaxActiveBlocksPerMultiprocessor(&per_cu, (const void*)fwd_megakernel, NTHR, LDS_BYTES) != hipSuccess || per_cu < 1) { fprintf(stderr, "kernel_launch: occupancy query gave %d\n", per_cu); per_cu = 1; }
        (void)hipGetLastError();
        grid = cus * 1;
    }
    if (grid < 0) return;
    (void)hipMemsetAsync((char*)d_ws + WS_BAR, 0, BAR_BYTES, stream);
    Args a{};
    for (int i = 0; i < 27; ++i) a.in[i] = (const float*)d_in[i];
    a.out = (float*)d_out; a.ws = (unsigned char*)d_ws;
    void* args[] = {&a};
    hipError_t e = hipLaunchCooperativeKernel((const void*)fwd_megakernel, dim3(grid), dim3(NTHR), args, LDS_BYTES, stream);
    if (e != hipSuccess) fprintf(stderr, "cooperative launch failed: %s (grid %d)\n", hipGetErrorString(e), grid);
}
```

```cpp
#include <hip/hip_runtime.h>
#include <hip/hip_bf16.h>
#include <hip/hip_cooperative_groups.h>
#include <cstdio>
#include <cstdint>
#include <cmath>
namespace cg = cooperative_groups;
namespace pg8 {
#define PG8_LAS __attribute__((address_space(3)))
typedef unsigned short bf16_t;
typedef short bf16x8 __attribute__((ext_vector_type(8)));
typedef float f32x4 __attribute__((ext_vector_type(4)));
typedef unsigned u32x4 __attribute__((ext_vector_type(4)));
constexpr int BM = 256, BK = 64, HALF = 128, HTB = HALF * BK * 2  , STAGE_BYTES = 8 * HTB, NXCD = 8, WGM = 4;

__host__ __device__ __forceinline__ int lds_byte(int r, int c) { const int st = (r >> 4) * 2 + (c >> 5), rr = r & 15, cc = c & 31, ob = rr * 64 + cc * 2; return st * 1024 + (ob ^ (((ob >> 9) & 1) << 5)); }
__host__ __device__ __forceinline__ void stage_rc(int b, int& R, int& C) { const int st = b / 1024, sb = b % 1024, swz = sb ^ (((sb >> 9) & 1) << 5); R = (st >> 1) * 16 + swz / 64; C = (st & 1) * 32 + (swz % 64) / 2; }
__host__ __device__ __forceinline__ int perm32(int rho) { const int n = rho >> 4, i = rho & 15; return 8 * (i >> 2) + 4 * n + (i & 3); }

struct Unit { int pm, pn; };
struct Gemm { const bf16_t* A; const bf16_t* Bt; int M, N, K; };

struct StaticOrder {
    int nM, nN, nwg, G, c;
    __host__ __device__ void init(int M, int N, int G_, int c_) { nM = M / BM; nN = N / BM; nwg = nM * nN; G = G_; c = c_; }
    __host__ __device__ bool next(int i, Unit& u) const {
        const long L = (long)i * G + c; if (L >= nwg) return false;
        int wgid = (int)L; { const int q = nwg / NXCD, r = nwg % NXCD, xcd = wgid % NXCD, off = wgid / NXCD; wgid = (xcd < r ? xcd * (q + 1) : r * (q + 1) + (xcd - r) * q) + off; }
        const int nig = WGM * nN, gid = wgid / nig, fm = gid * WGM, gsz = (nM - fm) < WGM ? (nM - fm) : WGM;
        u.pm = fm + ((wgid % nig) % gsz); u.pn = (wgid % nig) / gsz; return true;
    }
    __device__ __forceinline__ void a_ready(const Unit&) const {}
    __device__ __forceinline__ void done(const Unit&) const {}
};

__device__ __forceinline__ unsigned cvt_pk_bf16(float lo, float hi) { unsigned r; asm volatile("v_cvt_pk_bf16_f32 %0, %1, %2" : "=v"(r) : "v"(lo), "v"(hi)); return r; }
typedef float f32x2 __attribute__((ext_vector_type(2)));
__device__ __forceinline__ f32x2 gelu_pk(f32x2 v) {
    const f32x2 av = __builtin_elementwise_abs(v), d = av * 0.2316418882f + 1.0f;
    f32x2 t; t.x = __builtin_amdgcn_rcpf(d.x); t.y = __builtin_amdgcn_rcpf(d.y);
    f32x2 q = t * 0.5307027145f + (-0.7265760135f); q = q * t + 0.7107068705f; q = q * t + (-0.142248368f); q = q * t + 0.127414796f; q = q * t;
    const f32x2 s = (v * v) * (-0.72134752044f);
    f32x2 e; e.x = __builtin_amdgcn_exp2f(s.x); e.y = __builtin_amdgcn_exp2f(s.y);
    const f32x2 m = v * (q * e), r = v - m;
    f32x2 o; o.x = v.x < 0.f ? m.x : r.x; o.y = v.y < 0.f ? m.y : r.y; return o;
}

template <int ACT  > struct EpiBf16 {
    static constexpr bool PERM = true, AFTER_DRAIN = false; static_assert(ACT == 0 || ACT == 1, "EpiBf16: ACT is 0 (none) or 1 (gelu_pk)");
    bf16_t* O; int ldc; const float* bias; int split_cols; size_t split_stride; float scale0;
    __device__ __forceinline__ void operator()(const f32x4 (&acc)[2][2][4][2], const Unit& u, int wr, int wc, int fr, int fq) const {
        const int row0 = u.pm * BM + wr * 64 + fr; int colt = u.pn * BM; bf16_t* base = O;
        float sc = 1.f; if (split_cols) { const int t = colt / split_cols; base += (size_t)t * split_stride; colt -= t * split_cols; if (t == 0) sc = scale0; }
        const int col0 = colt + wc * 32 + 8 * fq, bcol0 = u.pn * BM + wc * 32 + 8 * fq;
        f32x4 bv[2][2];
#pragma unroll
        for (int bj = 0; bj < 2; ++bj)
#pragma unroll
            for (int n = 0; n < 2; ++n) bv[bj][n] = bias ? *(const f32x4*)(bias + bcol0 + bj * HALF + 4 * n) : (f32x4){0.f, 0.f, 0.f, 0.f};
#pragma unroll
        for (int ai = 0; ai < 2; ++ai)
#pragma unroll
            for (int m = 0; m < 4; ++m) { bf16_t* rowp = base + (size_t)(row0 + ai * HALF + m * 16) * ldc + col0;
#pragma unroll
                for (int bj = 0; bj < 2; ++bj) { f32x4 v0 = acc[ai][bj][m][0] + bv[bj][0], v1 = acc[ai][bj][m][1] + bv[bj][1];
                    if (ACT == 1) { f32x2 a = gelu_pk((f32x2){v0[0], v0[1]}), b = gelu_pk((f32x2){v0[2], v0[3]}), c = gelu_pk((f32x2){v1[0], v1[1]}), d = gelu_pk((f32x2){v1[2], v1[3]});
                        v0 = (f32x4){a.x, a.y, b.x, b.y}; v1 = (f32x4){c.x, c.y, d.x, d.y}; }
                    v0 = v0 * sc; v1 = v1 * sc; u32x4 w; w.x = cvt_pk_bf16(v0[0], v0[1]); w.y = cvt_pk_bf16(v0[2], v0[3]); w.z = cvt_pk_bf16(v1[0], v1[1]); w.w = cvt_pk_bf16(v1[2], v1[3]);
                    *(u32x4*)(rowp + bj * HALF) = w; } }
    }
};
template <class Epi, class Sched, bool ALIGN_EPI = false, bool SP2 = false>
__device__ __forceinline__ void gemm_phase(PG8_LAS unsigned char* lds, const Gemm g, const Sched& S, const Epi& E) {
    int tid_ = threadIdx.x; asm volatile("" : "+v"(tid_));
    const int tid = tid_, wid = __builtin_amdgcn_readfirstlane(tid >> 6), lane = tid & 63, wr = wid >> 2, wc = wid & 3, fr = lane & 15, fq = lane >> 4;
    const int K = g.K, nt = K / BK;
    unsigned voffA[2], voffB[2];
#pragma unroll
    for (int i = 0; i < 2; ++i) { int R, C; stage_rc(tid * 16 + i * 8192, R, C); const int Rb = Epi::PERM ? ((R & ~31) + perm32(R & 31)) : R;
        voffA[i] = (unsigned)(R * K + C) * 2u; voffB[i] = (unsigned)(Rb * K + C) * 2u; }
    const size_t kstep = (size_t)(BK * 2);
    const size_t hstep = (size_t)HALF * K * 2;
    const size_t tstep = 2 * hstep;
    const unsigned ldsw = (unsigned)wid * 1024u;
    const int aoff = lds_byte(wr * 64 + fr, fq * 8), boff = lds_byte(wc * 32 + fr, fq * 8);
#define PG8_SA(b, h) (((b) * 2 + (h)) * HTB)
#define PG8_SB(b, h) ((4 + (b) * 2 + (h)) * HTB)
#define PG8_STAGE(bufoff, gbase, voff) do { _Pragma("unroll") for (int _i = 0; _i < 2; ++_i) \
        __builtin_amdgcn_global_load_lds((const unsigned*)((const char*)(gbase) + (voff)[_i]), (PG8_LAS unsigned*)(lds + (bufoff) + ldsw + _i * 8192), 16, 0, 0); } while (0)
#define PG8_LDA(dst, b, h) do { _Pragma("unroll") for (int m = 0; m < 4; ++m) _Pragma("unroll") for (int k = 0; k < 2; ++k) dst[m][k] = *(const PG8_LAS bf16x8*)(lds + PG8_SA(b, h) + aoff + m * 2048 + k * 1024); } while (0)
#define PG8_LDB(dst, b, h) do { _Pragma("unroll") for (int n = 0; n < 2; ++n) _Pragma("unroll") for (int k = 0; k < 2; ++k) dst[n][k] = *(const PG8_LAS bf16x8*)(lds + PG8_SB(b, h) + boff + n * 2048 + k * 1024); } while (0)
#define PG8_MMA(ai, bj, At, Bt) do { __builtin_amdgcn_s_setprio(1); _Pragma("unroll") for (int m = 0; m < 4; ++m) _Pragma("unroll") for (int n = 0; n < 2; ++n) _Pragma("unroll") for (int k = 0; k < 2; ++k) \
        acc[ai][bj][m][n] = __builtin_amdgcn_mfma_f32_16x16x32_bf16(Bt[n][k], At[m][k], acc[ai][bj][m][n], 0, 0, 0); __builtin_amdgcn_s_setprio(0); } while (0)
#define PG8_WAIT_V(n) asm volatile("s_waitcnt vmcnt(" #n ")" ::: "memory")
#define PG8_WAIT_L(n) asm volatile("s_waitcnt lgkmcnt(" #n ")" ::: "memory")
#define PG8_BAR __builtin_amdgcn_s_barrier()
#define PG8_SCHED __builtin_amdgcn_sched_barrier(0)
    Unit cur, nxt; int ui = 0;
    if (!S.next(0, cur)) return;
    f32x4 acc[2][2][4][2];
#pragma unroll
    for (int a = 0; a < 2; ++a)
#pragma unroll
        for (int b = 0; b < 2; ++b)
#pragma unroll
            for (int m = 0; m < 4; ++m)
#pragma unroll
                for (int n = 0; n < 2; ++n) acc[a][b][m][n] = (f32x4){0.f, 0.f, 0.f, 0.f};
    bf16x8 At[4][2], B0[2][2], B1[2][2];
    const char* cA = (const char*)g.A + (size_t)cur.pm * tstep; const char* cB = (const char*)g.Bt + (size_t)cur.pn * tstep;
    S.a_ready(cur);
    if constexpr (SP2) {
        PG8_STAGE(PG8_SB(0, 0), cB, voffB); PG8_STAGE(PG8_SB(0, 1), cB + hstep, voffB); PG8_STAGE(PG8_SA(0, 0), cA, voffA); PG8_STAGE(PG8_SA(0, 1), cA + hstep, voffA);
        if (wr == 1) PG8_BAR;
        PG8_WAIT_V(2); PG8_BAR;
        PG8_STAGE(PG8_SB(1, 0), cB + kstep, voffB); PG8_STAGE(PG8_SA(1, 0), cA + kstep, voffA); PG8_STAGE(PG8_SB(1, 1), cB + hstep + kstep, voffB);
        PG8_WAIT_V(6); PG8_BAR;
    } else {
        PG8_STAGE(PG8_SB(0, 0), cB, voffB); PG8_STAGE(PG8_SA(0, 0), cA, voffA); PG8_STAGE(PG8_SB(0, 1), cB + hstep, voffB); PG8_STAGE(PG8_SA(0, 1), cA + hstep, voffA);
        if (wr == 1) PG8_BAR;
        PG8_WAIT_V(4); PG8_BAR;
        PG8_STAGE(PG8_SB(1, 0), cB + kstep, voffB); PG8_STAGE(PG8_SA(1, 0), cA + kstep, voffA); PG8_STAGE(PG8_SB(1, 1), cB + hstep + kstep, voffB);
        PG8_WAIT_V(6); PG8_BAR;
    }
    for (;;) {
        const bool has_next = S.next(ui + 1, nxt);
        const char* nA = has_next ? (const char*)g.A + (size_t)nxt.pm * tstep : cA; const char* nB = has_next ? (const char*)g.Bt + (size_t)nxt.pn * tstep : cB;
        for (int t = 0; t < nt; t += 2) {
            const bool last = (t == nt - 2);
            const char* a1 = cA + (size_t)(t + 1) * kstep;
            const char* a2 = last ? nA : cA + (size_t)(t + 2) * kstep; const char* b2 = last ? nB : cB + (size_t)(t + 2) * kstep;
            const char* a3 = a2 + kstep; const char* b3 = b2 + kstep;
            if (last && has_next) S.a_ready(nxt);
            if constexpr (SP2) {
            PG8_LDB(B0, 0, 0); PG8_LDB(B1, 0, 1); PG8_SCHED; PG8_LDA(At, 0, 0); PG8_STAGE(PG8_SA(1, 1), a1 + hstep, voffA);
            PG8_WAIT_V(8); PG8_WAIT_L(0); PG8_BAR; PG8_MMA(0, 0, At, B0); PG8_MMA(0, 1, At, B1); PG8_BAR; PG8_SCHED;
            PG8_LDA(At, 0, 1); PG8_STAGE(PG8_SB(0, 0), b2, voffB); PG8_STAGE(PG8_SB(0, 1), b2 + hstep, voffB); PG8_STAGE(PG8_SA(0, 0), a2, voffA);
            PG8_WAIT_V(8); PG8_WAIT_L(0); PG8_BAR; PG8_MMA(1, 0, At, B0); PG8_MMA(1, 1, At, B1); PG8_BAR; PG8_SCHED;
            PG8_LDB(B0, 1, 0); PG8_LDB(B1, 1, 1); PG8_SCHED; PG8_LDA(At, 1, 0); PG8_STAGE(PG8_SA(0, 1), a2 + hstep, voffA);
            PG8_WAIT_V(8); PG8_WAIT_L(0); PG8_BAR; PG8_MMA(0, 0, At, B0); PG8_MMA(0, 1, At, B1); PG8_BAR; PG8_SCHED;
            PG8_LDA(At, 1, 1); PG8_STAGE(PG8_SB(1, 0), b3, voffB); PG8_STAGE(PG8_SB(1, 1), b3 + hstep, voffB); PG8_STAGE(PG8_SA(1, 0), a3, voffA);
            PG8_WAIT_V(8); PG8_WAIT_L(0); PG8_BAR; PG8_MMA(1, 0, At, B0); PG8_MMA(1, 1, At, B1); PG8_BAR; PG8_SCHED;
            } else {
            PG8_LDB(B0, 0, 0); PG8_SCHED; PG8_LDA(At, 0, 0); PG8_STAGE(PG8_SA(1, 1), a1 + hstep, voffA);
            PG8_WAIT_L(8); PG8_BAR; PG8_WAIT_L(0); PG8_MMA(0, 0, At, B0); PG8_BAR; PG8_SCHED;
            PG8_LDB(B1, 0, 1); PG8_STAGE(PG8_SB(0, 0), b2, voffB);
            PG8_BAR; PG8_WAIT_L(0); PG8_MMA(0, 1, At, B1); PG8_BAR;
            PG8_LDA(At, 0, 1); PG8_STAGE(PG8_SA(0, 0), a2, voffA);
            PG8_BAR; PG8_WAIT_L(0); PG8_MMA(1, 0, At, B0); PG8_BAR; PG8_SCHED;
            PG8_STAGE(PG8_SB(0, 1), b2 + hstep, voffB);
            PG8_WAIT_V(6); PG8_BAR; PG8_MMA(1, 1, At, B1); PG8_BAR;
            PG8_LDB(B0, 1, 0); PG8_SCHED; PG8_LDA(At, 1, 0); PG8_STAGE(PG8_SA(0, 1), a2 + hstep, voffA);
            PG8_WAIT_L(8); PG8_BAR; PG8_WAIT_L(0); PG8_MMA(0, 0, At, B0); PG8_BAR; PG8_SCHED;
            PG8_LDB(B1, 1, 1); PG8_STAGE(PG8_SB(1, 0), b3, voffB);
            PG8_BAR; PG8_WAIT_L(0); PG8_MMA(0, 1, At, B1); PG8_BAR;
            PG8_LDA(At, 1, 1); PG8_STAGE(PG8_SA(1, 0), a3, voffA);
            PG8_BAR; PG8_WAIT_L(0); PG8_MMA(1, 0, At, B0); PG8_BAR; PG8_SCHED;
            PG8_STAGE(PG8_SB(1, 1), b3 + hstep, voffB);
            PG8_WAIT_V(6); PG8_BAR; PG8_MMA(1, 1, At, B1); PG8_BAR;
            }
        }
        if constexpr (ALIGN_EPI) { if (wr == 0) PG8_BAR; }
        if constexpr (!Epi::AFTER_DRAIN) { E(acc, cur, wr, wc, fr, fq); S.done(cur); }
        if (!has_next) break;
#pragma unroll
        for (int a = 0; a < 2; ++a)
#pragma unroll
            for (int b = 0; b < 2; ++b)
#pragma unroll
                for (int m = 0; m < 4; ++m)
#pragma unroll
                    for (int n = 0; n < 2; ++n) acc[a][b][m][n] = (f32x4){0.f, 0.f, 0.f, 0.f};
        cur = nxt; cA = nA; cB = nB; ++ui;
        if constexpr (ALIGN_EPI) { if (wr == 1) PG8_BAR; }
    }
    PG8_WAIT_V(0);
    if constexpr (!ALIGN_EPI) { if (wr == 0) PG8_BAR; }
    PG8_BAR;
    if constexpr (Epi::AFTER_DRAIN) { E.fused(acc, cur, wr, wc, fr, fq, lds, wid, lane); S.done(cur); }
#undef PG8_SA
#undef PG8_SB
#undef PG8_STAGE
#undef PG8_LDA
#undef PG8_LDB
#undef PG8_MMA
#undef PG8_WAIT_V
#undef PG8_WAIT_L
#undef PG8_BAR
#undef PG8_SCHED
}
}
#include <hip/hip_bf16.h>
namespace attn_body {
using bf16=__hip_bfloat16;
using bf16x8=__attribute__((ext_vector_type(8)))short;
using s16x4=__attribute__((ext_vector_type(4)))short;
using f32x16=__attribute__((ext_vector_type(16)))float;
using u32x4=__attribute__((ext_vector_type(4)))unsigned;
constexpr int D=64,PQ=2304,PO=1536;
constexpr int NW=8,QBLK=32,QB=QBLK*NW,KVBLK=64;
__device__ __forceinline__ int crow(int r,int hi){return (r&3)+8*(r>>2)+4*hi;}
#define SBAR() __builtin_amdgcn_sched_barrier(0)
__device__ __forceinline__ void cmask(f32x16&p0,f32x16&p1,int jb,int qrel,int hi){
  const float NEG=-INFINITY; int kb=64*jb+4*hi;
  #pragma unroll
  for(int r=0;r<16;++r){int kv=kb+(r&3)+8*(r>>2); if(kv>qrel)p0[r]=NEG; if(kv+32>qrel)p1[r]=NEG;}
}

constexpr int NSLOT=3, SLOTB=8192;
constexpr int LDS_K=0, LDS_V=NSLOT*SLOTB, LDS_WS=2*NSLOT*SLOTB, LDS_OST=LDS_WS+NW*64*4, LDS_BYTES=LDS_OST+NW*4096;
constexpr float C2=0.125f*1.4426950408889634f;
__device__ __forceinline__ void glds16(const void*gsrc,unsigned lds_dst){unsigned keep;
  asm volatile("s_mov_b32 %0, m0\n\ts_mov_b32 m0, %2\n\ts_nop 0\n\tglobal_load_lds_dwordx4 %1, off\n\ts_mov_b32 m0, %0":"=&s"(keep):"v"(gsrc),"s"(lds_dst):"memory");}
__device__ __forceinline__ float max3f(float a,float b,float c){float r;asm("v_max3_f32 %0, %1, %2, %3":"=v"(r):"v"(a),"v"(b),"v"(c));return r;}
__device__ __forceinline__ float max2f(float a,float b){float r;asm("v_max_f32_e32 %0, %1, %2":"=v"(r):"v"(a),"v"(b));return r;}
__device__ __forceinline__ float fadd_s(float a,float b){float r;asm("v_add_f32_e32 %0, %1, %2":"=v"(r):"v"(a),"v"(b));return r;}
__device__ __forceinline__ float fsub_s(float a,float b){float r;asm("v_sub_f32_e32 %0, %1, %2":"=v"(r):"v"(a),"v"(b));return r;}
typedef float f32x2_t __attribute__((ext_vector_type(2))); typedef __bf16 bf16x2_t __attribute__((ext_vector_type(2)));
__device__ __forceinline__ unsigned cvtpk_s(float lo,float hi){f32x2_t v={lo,hi};bf16x2_t b=__builtin_convertvector(v,bf16x2_t);return __builtin_bit_cast(unsigned,b);}
#define WAIT_BAR(N) asm volatile("s_waitcnt vmcnt(" #N ") lgkmcnt(0)\n\ts_barrier":::"memory")

__device__ __forceinline__ void qkt(f32x16&p0,f32x16&p1,const char*Kslot,const bf16x8*qr,const f32x16&negm,int r32,int hi){
  const char*kb=Kslot+hi*1024+r32*16;
  #pragma unroll
  for(int d0=0;d0<4;++d0){
    const bf16x8 b0=*reinterpret_cast<const bf16x8*>(kb+d0*2048);
    const bf16x8 b1=*reinterpret_cast<const bf16x8*>(kb+d0*2048+512);
    if(d0==0){p0=__builtin_amdgcn_mfma_f32_32x32x16_bf16(b0,qr[0],negm,0,0,0);p1=__builtin_amdgcn_mfma_f32_32x32x16_bf16(b1,qr[0],negm,0,0,0);}
    else{p0=__builtin_amdgcn_mfma_f32_32x32x16_bf16(b0,qr[d0],p0,0,0,0);p1=__builtin_amdgcn_mfma_f32_32x32x16_bf16(b1,qr[d0],p1,0,0,0);}}
}
typedef __attribute__((address_space(3))) const char* lds_cptr;
typedef short v4i16_t __attribute__((ext_vector_type(4)));
__device__ __forceinline__ void kload8(bf16x8*kf,lds_cptr kp){
  kf[0]=*(const __attribute__((address_space(3))) bf16x8*)(kp);      kf[1]=*(const __attribute__((address_space(3))) bf16x8*)(kp+512);
  kf[2]=*(const __attribute__((address_space(3))) bf16x8*)(kp+2048); kf[3]=*(const __attribute__((address_space(3))) bf16x8*)(kp+2560);
  kf[4]=*(const __attribute__((address_space(3))) bf16x8*)(kp+4096); kf[5]=*(const __attribute__((address_space(3))) bf16x8*)(kp+4608);
  kf[6]=*(const __attribute__((address_space(3))) bf16x8*)(kp+6144); kf[7]=*(const __attribute__((address_space(3))) bf16x8*)(kp+6656);
}
__device__ __forceinline__ void kload2(bf16x8*kf,lds_cptr kp,int j){ kf[2*j]=*(const __attribute__((address_space(3))) bf16x8*)(kp+j*2048); kf[2*j+1]=*(const __attribute__((address_space(3))) bf16x8*)(kp+j*2048+512); }
__device__ __forceinline__ s16x4 vtr(lds_cptr p){ return __builtin_bit_cast(s16x4,__builtin_amdgcn_ds_read_tr16_b64_v4i16((__attribute__((address_space(3))) v4i16_t*)p)); }
__device__ __forceinline__ float rowmax(const f32x16&p0,const f32x16&p1){
  float a=max3f(p0[0],p0[1],p1[0]),b=max3f(p0[2],p0[3],p1[1]);a=max3f(a,p1[2],p1[3]);
  #pragma unroll
  for(int r=4;r<16;r+=4){a=max3f(a,p0[r],p0[r+1]);b=max3f(b,p0[r+2],p0[r+3]);a=max3f(a,p1[r],p1[r+1]);b=max3f(b,p1[r+2],p1[r+3]);}
  const float m=max2f(a,b);
  auto rr=__builtin_amdgcn_permlane32_swap(__float_as_uint(m),__float_as_uint(m),false,false);
  return max2f(__uint_as_float(rr[0]),__uint_as_float(rr[1]));
}
__device__ __forceinline__ void pv(f32x16*o,int vb,bf16x8 pa0,bf16x8 pa1,bf16x8 pa2,bf16x8 pa3){
  #pragma unroll
  for(int d0=0;d0<2;++d0){s16x4 lo[4],hi[4];
    #pragma unroll
    for(int ks=0;ks<4;++ks){
      asm volatile("ds_read_b64_tr_b16 %0,%1 offset:%c2":"=&v"(lo[ks]):"v"(vb),"i"(d0*4096+ks*1024):"memory");
      asm volatile("ds_read_b64_tr_b16 %0,%1 offset:%c2":"=&v"(hi[ks]):"v"(vb),"i"(d0*4096+ks*1024+512):"memory");}
    asm volatile("s_waitcnt lgkmcnt(0)":::"memory");SBAR();
    #define PK(k) (bf16x8){lo[k][0],lo[k][1],lo[k][2],lo[k][3],hi[k][0],hi[k][1],hi[k][2],hi[k][3]}
    o[d0]=__builtin_amdgcn_mfma_f32_32x32x16_bf16(pa0,PK(0),o[d0],0,0,0);
    o[d0]=__builtin_amdgcn_mfma_f32_32x32x16_bf16(pa1,PK(1),o[d0],0,0,0);
    o[d0]=__builtin_amdgcn_mfma_f32_32x32x16_bf16(pa2,PK(2),o[d0],0,0,0);
    o[d0]=__builtin_amdgcn_mfma_f32_32x32x16_bf16(pa3,PK(3),o[d0],0,0,0);
    #undef PK
  }
}

#ifndef ATTN_STORE16
#define ATTN_STORE16(p,v) (*(u32x4*)(p)=(v))
#endif
template<int THRL> __device__ __forceinline__ void attn_unit(const bf16*Qblk,const bf16*__restrict__ Kh,const bf16*__restrict__ Vh,bf16*Oblk,const int po,const int NT,char*shm){
  int tid_=threadIdx.x; asm volatile("":"+v"(tid_));
  const int tid=tid_,lane=tid&63,r32=lane&31,hi=lane>>5; const int wid=__builtin_amdgcn_readfirstlane(tid>>6);
  const bf16*Qw=Qblk+(long)wid*QBLK*PQ;
  const unsigned lds0=(unsigned)(uintptr_t)shm;
  float*wsf=(float*)(shm+LDS_WS)+wid*64;
  const bf16*ksrc=Kh+(long)lane*PQ+wid*8;
  const bf16*vsrc=Vh+(long)(16*(wid&3)+(lane>>2))*PQ+(wid>>2)*32+(lane&3)*8;
  const unsigned kdst=lds0+LDS_K+wid*1024, vdst=lds0+LDS_V+wid*1024;
  #define DMA_K(t,slot) glds16(ksrc+(long)(t)*KVBLK*PQ,(unsigned)__builtin_amdgcn_readfirstlane(kdst+(slot)))
  #define DMA_V(t,slot) glds16(vsrc+(long)(t)*KVBLK*PQ,(unsigned)__builtin_amdgcn_readfirstlane(vdst+(slot)))
  const int vb0=(int)(lds0+LDS_V)+((lane>>4)&1)*32+(lane&3)*8+(4*hi+((lane&15)>>2))*64;
  const char*Kbase=shm+LDS_K; bf16x8 kf[8];
  const lds_cptr shm3=(lds_cptr)shm; const lds_cptr kp0=shm3+LDS_K+hi*1024+r32*16; const lds_cptr vp0=shm3+LDS_V+((lane>>4)&1)*32+(lane&3)*8+(4*hi+((lane&15)>>2))*64;
  DMA_K(0,0);DMA_V(0,0);DMA_K(1,SLOTB);
  bf16x8 qr[4];
  #pragma unroll
  for(int d0=0;d0<4;++d0)qr[d0]=*reinterpret_cast<const bf16x8*>(&Qw[(long)r32*PQ+d0*16+hi*8]);
  float mhat=0.f,l_reg=0.f;f32x16 o[2];o[0]=f32x16{};o[1]=f32x16{};f32x16 negm=f32x16{};asm volatile("":"+v"(negm));
  #define CMASK(P0,P1,t) do{}while(0)
  bool resc=false;
  #define START(P0,P1) do{ const float rm=rowmax(P0,P1); resc=false; \
    { const float dl=rm; mhat=fadd_s(mhat,dl); \
      _Pragma("unroll") for(int r=0;r<16;++r){P0[r]=fsub_s(P0[r],dl);P1[r]=fsub_s(P1[r],dl);} \
      _Pragma("unroll") for(int r=0;r<16;++r)negm[r]=-mhat; asm volatile("":"+v"(negm)); } \
    _Pragma("unroll") for(int r=0;r<16;++r)P0[r]=__builtin_amdgcn_exp2f(P0[r]); }while(0)
  #define RESC() do{ if(resc){ asm volatile("s_waitcnt lgkmcnt(0)":::"memory"); \
      _Pragma("unroll") for(int d_=0;d_<2;++d_) _Pragma("unroll") for(int r=0;r<16;++r)o[d_][r]*=wsf[crow(r,hi)]; } }while(0)
  f32x16 pA0,pA1,pB0,pB1;
  int sl_prev=0,sl_cur=0,sl_next=SLOTB;
  #define ROT() do{sl_prev=sl_cur;sl_cur=sl_next;sl_next=(sl_next==(NSLOT-1)*SLOTB)?0:sl_next+SLOTB;}while(0)
  DMA_K(2,2*SLOTB);
  WAIT_BAR(3);
  qkt(pA0,pA1,Kbase,qr,negm,r32,hi);asm volatile("s_nop 15\n\ts_nop 7":"+v"(pA0),"+v"(pA1));CMASK(pA0,pA1,0);
  START(pA0,pA1);
  _Pragma("unroll") for(int r=0;r<16;++r)pA1[r]=__builtin_amdgcn_exp2f(pA1[r]);
  WAIT_BAR(0);
  DMA_K(3,0);DMA_V(1,SLOTB);
  ROT();
  kload8(kf,kp0+sl_cur);
  WAIT_BAR(2);
  s16x4 vlo[8],vhi[8]; u32x4 pw0,pw1,pw2,pw3;
  #define PKW(P,B) cvtpk_s(P[B],P[B+1])
  #define PAF(k) __builtin_bit_cast(bf16x8,pw##k)
  #define VFR(i) (bf16x8){vlo[i][0],vlo[i][1],vlo[i][2],vlo[i][3],vhi[i][0],vhi[i][1],vhi[i][2],vhi[i][3]}
  #define PIN(x) asm volatile("":"+v"(x))
  #define MX3(a,b,c) __builtin_fmaxf(__builtin_fmaxf((a),(b)),(c))
  #define GAPA(MF,A0,A1,A2,A3,W0,W1,PW) do{ MF; sacc+=A0; sacc+=A1; sacc+=A2; sacc+=A3; PIN(sacc); W0; W1; PIN(PW); SBAR(); }while(0)
  #define EX(v) __builtin_amdgcn_exp2f(v)
  #define GAPB(MF,X,B) do{ MF; X[B]=EX(X[B]); X[B+1]=EX(X[B+1]); X[B+2]=EX(X[B+2]); X[B+3]=EX(X[B+3]); PIN(X); SBAR(); }while(0)
  #define VRD(i) do{ vlo[i]=vtr(vp_+(((i)>>2)*4096+((i)&3)*1024)); vhi[i]=vtr(vp_+(((i)>>2)*4096+((i)&3)*1024+512)); }while(0)
  #define KRD(G,j) do{ if(G){ kload2(kf,kp0+sl_next,j); SBAR(); } }while(0)
  #define STEP(C0,C1,P0,P1,t,GK,GV,GL) do{ SBAR(); \
    const lds_cptr vp_=vp0+sl_prev; \
    VRD(0); SBAR(); float sacc=(P0[0]+P0[1]); \
    GAPA(C0=__builtin_amdgcn_mfma_f32_32x32x16_bf16(kf[0],qr[0],negm,0,0,0), P0[2],P0[3],P0[4],P0[5],     pw0[0]=PKW(P0,0), pw0[1]=PKW(P0,2), pw0); \
    VRD(4); SBAR(); GAPA(C1=__builtin_amdgcn_mfma_f32_32x32x16_bf16(kf[1],qr[0],negm,0,0,0), P0[6],P0[7],P0[8],P0[9],     pw0[2]=PKW(P0,4), pw0[3]=PKW(P0,6), pw0); \
    VRD(1); SBAR(); GAPA(C0=__builtin_amdgcn_mfma_f32_32x32x16_bf16(kf[2],qr[1],C0,0,0,0),   P0[10],P0[11],P0[12],P0[13], pw1[0]=PKW(P0,8), pw1[1]=PKW(P0,10), pw1); \
    VRD(5); SBAR(); GAPA(C1=__builtin_amdgcn_mfma_f32_32x32x16_bf16(kf[3],qr[1],C1,0,0,0),   P0[14],P0[15],P1[0],P1[1],   pw1[2]=PKW(P0,12),pw1[3]=PKW(P0,14), pw1); \
    VRD(2); SBAR(); GAPA(C0=__builtin_amdgcn_mfma_f32_32x32x16_bf16(kf[4],qr[2],C0,0,0,0),   P1[2],P1[3],P1[4],P1[5],     pw2[0]=PKW(P1,0), pw2[1]=PKW(P1,2), pw2); \
    VRD(6); SBAR(); GAPA(C1=__builtin_amdgcn_mfma_f32_32x32x16_bf16(kf[5],qr[2],C1,0,0,0),   P1[6],P1[7],P1[8],P1[9],     pw2[2]=PKW(P1,4), pw2[3]=PKW(P1,6), pw2); \
    VRD(3); SBAR(); GAPA(C0=__builtin_amdgcn_mfma_f32_32x32x16_bf16(kf[6],qr[3],C0,0,0,0),   P1[10],P1[11],P1[12],P1[13], pw3[0]=PKW(P1,8), pw3[1]=PKW(P1,10), pw3); \
    VRD(7); SBAR(); GAPA(C1=__builtin_amdgcn_mfma_f32_32x32x16_bf16(kf[7],qr[3],C1,0,0,0),   P1[14],P1[15],0.f,0.f,       pw3[2]=PKW(P1,12),pw3[3]=PKW(P1,14), pw3); \
    l_reg+=sacc; \
    if(GK){DMA_K((t)+3,sl_cur);} if(GV){DMA_V((t)+1,sl_next);} \
    CMASK(C0,C1,t); \
    { float a=MX3(C0[0],C0[1],C1[0]),b=MX3(C0[2],C0[3],C1[1]); a=MX3(a,C1[2],C1[3]); \
      _Pragma("unroll") for(int r=4;r<16;r+=4){a=MX3(a,C0[r],C0[r+1]);b=MX3(b,C0[r+2],C0[r+3]);a=MX3(a,C1[r],C1[r+1]);b=MX3(b,C1[r+2],C1[r+3]);} \
      float rm=__builtin_fmaxf(a,b); { auto rr=__builtin_amdgcn_permlane32_swap(__float_as_uint(rm),__float_as_uint(rm),false,false); rm=__builtin_fmaxf(__uint_as_float(rr[0]),__uint_as_float(rr[1])); } \
      resc=false; \
      if(__builtin_expect(__any(rm>(float)THRL),0)){ const float dl=__builtin_fmaxf(rm,0.f); mhat+=dl; \
        _Pragma("unroll") for(int r=0;r<16;++r){C0[r]-=dl;C1[r]-=dl;} \
        _Pragma("unroll") for(int r=0;r<16;++r)negm[r]=-mhat; asm volatile("":"+v"(negm)); \
        const float f=__builtin_amdgcn_exp2f(-dl); l_reg*=f; if(hi==0)wsf[r32]=f; resc=true; } } \
    SBAR(); \
    GAPB(o[0]=__builtin_amdgcn_mfma_f32_32x32x16_bf16(PAF(0),VFR(0),o[0],0,0,0), C0,0); \
    GAPB(o[1]=__builtin_amdgcn_mfma_f32_32x32x16_bf16(PAF(0),VFR(4),o[1],0,0,0), C0,4); \
    KRD(GL,0); GAPB(o[0]=__builtin_amdgcn_mfma_f32_32x32x16_bf16(PAF(1),VFR(1),o[0],0,0,0), C0,8); \
    KRD(GL,1); GAPB(o[1]=__builtin_amdgcn_mfma_f32_32x32x16_bf16(PAF(1),VFR(5),o[1],0,0,0), C0,12); \
    KRD(GL,2); GAPB(o[0]=__builtin_amdgcn_mfma_f32_32x32x16_bf16(PAF(2),VFR(2),o[0],0,0,0), C1,0); \
    KRD(GL,3); GAPB(o[1]=__builtin_amdgcn_mfma_f32_32x32x16_bf16(PAF(2),VFR(6),o[1],0,0,0), C1,4); \
    GAPB(o[0]=__builtin_amdgcn_mfma_f32_32x32x16_bf16(PAF(3),VFR(3),o[0],0,0,0), C1,8); \
    GAPB(o[1]=__builtin_amdgcn_mfma_f32_32x32x16_bf16(PAF(3),VFR(7),o[1],0,0,0), C1,12); \
    }while(0)
  int t=1;
  #undef CMASK
  #define CMASK(P0,P1,t) do{}while(0)
  for(;t+5<NT;t+=2){
    STEP(pB0,pB1,pA0,pA1,t,true,true,true);     WAIT_BAR(2); RESC(); ROT();
    STEP(pA0,pA1,pB0,pB1,t+1,true,true,true);   WAIT_BAR(2); RESC(); ROT();
  }
  #undef CMASK
  #define CMASK(P0,P1,t) do{}while(0)
  #define ENDW(tt) do{ if((tt)+3<NT){WAIT_BAR(2);} else if((tt)+2<NT){WAIT_BAR(1);} else {WAIT_BAR(0);} }while(0)
  for(;t+1<NT;t+=2){
    STEP(pB0,pB1,pA0,pA1,t,(t+3<NT),(t+1<NT),(t+1<NT));       ENDW(t);   RESC(); ROT();
    STEP(pA0,pA1,pB0,pB1,t+1,(t+4<NT),(t+2<NT),(t+2<NT));     ENDW(t+1); RESC(); ROT();
  }
  STEP(pB0,pB1,pA0,pA1,NT-1,false,false,false); RESC();
  { float sacc=pB0[0]+pB0[1]; _Pragma("unroll") for(int r=2;r<16;++r)sacc+=pB0[r]; _Pragma("unroll") for(int r=0;r<16;++r)sacc+=pB1[r]; l_reg+=sacc;
    pw0=(u32x4){PKW(pB0,0),PKW(pB0,2),PKW(pB0,4),PKW(pB0,6)};pw1=(u32x4){PKW(pB0,8),PKW(pB0,10),PKW(pB0,12),PKW(pB0,14)};pw2=(u32x4){PKW(pB1,0),PKW(pB1,2),PKW(pB1,4),PKW(pB1,6)};pw3=(u32x4){PKW(pB1,8),PKW(pB1,10),PKW(pB1,12),PKW(pB1,14)};
    SBAR(); pv(o,vb0+sl_cur,PAF(0),PAF(1),PAF(2),PAF(3)); }
  #undef PKW
  #undef PAF
  #undef VFR
  #undef PIN
  #undef MX3
  #undef GAPA
  #undef GAPB
  #undef EX
  #undef VRD
  #undef KRD
  #undef STEP
  #undef ENDW
  {auto rr=__builtin_amdgcn_permlane32_swap(__float_as_uint(l_reg),__float_as_uint(l_reg),false,false);l_reg=__uint_as_float(rr[0])+__uint_as_float(rr[1]);}
  if(hi==0)wsf[32+r32]=l_reg;asm volatile("s_waitcnt lgkmcnt(0)":::"memory");
  float rli[16];
  #pragma unroll
  for(int r=0;r<16;++r)rli[r]=__builtin_amdgcn_rcpf(wsf[32+crow(r,hi)]);
  bf16*Ow=Oblk+(long)wid*QBLK*po;
  { bf16*stg=(bf16*)(shm+LDS_OST)+wid*2048;
    #pragma unroll
    for(int r=0;r<16;++r){const int orow=crow(r,hi);
      #pragma unroll
      for(int d0=0;d0<2;++d0)stg[orow*64+d0*32+r32]=__float2bfloat16(o[d0][r]*rli[r]);}
    asm volatile("s_waitcnt lgkmcnt(0)":::"memory");
    #pragma unroll
    for(int i=0;i<4;++i){const int row=i*8+(lane>>3),ch=lane&7; const u32x4 v=*(const u32x4*)(stg+row*64+ch*8); ATTN_STORE16(Ow+(long)row*po+ch*8,v);} }
  asm volatile("s_waitcnt lgkmcnt(0)\n\ts_barrier":::"memory");
  #undef DMA_K
  #undef DMA_V
  #undef CMASK
  #undef START
  #undef RESC
  #undef ROT
}
constexpr int LDS_WS8=LDS_V+3*2*SLOTB, LDS_OST8=LDS_WS8+NW*64*4, LDS_BYTES8=LDS_OST8+NW*8192;
typedef float f32x4_t __attribute__((ext_vector_type(4)));
template<int THRL,int MODE> __device__ __forceinline__ void attn_unit128(const bf16*Qblk,const bf16*__restrict__ Kh,const bf16*__restrict__ Vh,bf16*Oblk,const int NT,char*shm,const bf16*O1blk,bf16*AOblk,const float lam,const float*sln,const float omli){
  int tid_=threadIdx.x; asm volatile("":"+v"(tid_));
  const int tid=tid_,lane=tid&63,r32=lane&31,hi=lane>>5; const int wid=__builtin_amdgcn_readfirstlane(tid>>6);
  const bf16*Qw=Qblk+(long)wid*QBLK*PQ;
  const unsigned lds0=(unsigned)(uintptr_t)shm;
  float*wsf=(float*)(shm+LDS_WS8)+wid*64;
  const unsigned koff=(unsigned)(lane*PQ+wid*8)*2u;
  const unsigned voff=(unsigned)((16*(wid&3)+(lane>>2))*PQ+(wid>>2)*32+(lane&3)*8)*2u;
  const unsigned kdst=lds0+LDS_K+wid*1024, vdst=lds0+LDS_V+wid*1024;
  #define DMA_K(t,slot) glds16((const char*)Kh+(size_t)(t)*(KVBLK*PQ*2)+koff,(unsigned)__builtin_amdgcn_readfirstlane(kdst+(slot)))
  #define DMA_V(t,slot) do{ glds16((const char*)Vh+(size_t)(t)*(KVBLK*PQ*2)+voff,(unsigned)__builtin_amdgcn_readfirstlane(vdst+2*(slot))); glds16((const char*)Vh+(size_t)(t)*(KVBLK*PQ*2)+128+voff,(unsigned)__builtin_amdgcn_readfirstlane(vdst+2*(slot)+8192)); }while(0)
  const char*Kbase=shm+LDS_K; bf16x8 kf[8];
  const lds_cptr shm3=(lds_cptr)shm; const lds_cptr kp0=shm3+LDS_K+hi*1024+r32*16; const lds_cptr vp0=shm3+LDS_V+((lane>>4)&1)*32+(lane&3)*8+(4*hi+((lane&15)>>2))*64;
  DMA_K(0,0);DMA_V(0,0);DMA_K(1,SLOTB);
  bf16x8 qr[4];
  #pragma unroll
  for(int d0=0;d0<4;++d0)qr[d0]=*reinterpret_cast<const bf16x8*>(&Qw[(long)r32*PQ+d0*16+hi*8]);
  float mhat=0.f,l_reg=0.f;f32x16 o[4];o[0]=f32x16{};o[1]=f32x16{};o[2]=f32x16{};o[3]=f32x16{};f32x16 negm=f32x16{};asm volatile("":"+v"(negm));
  #define CMASK(P0,P1,t) do{}while(0)
  bool resc=false;
  #define START(P0,P1) do{ const float rm=rowmax(P0,P1); resc=false; \
    { const float dl=rm; mhat=fadd_s(mhat,dl); \
      _Pragma("unroll") for(int r=0;r<16;++r){P0[r]=fsub_s(P0[r],dl);P1[r]=fsub_s(P1[r],dl);} \
      _Pragma("unroll") for(int r=0;r<16;++r)negm[r]=-mhat; asm volatile("":"+v"(negm)); } \
    _Pragma("unroll") for(int r=0;r<16;++r)P0[r]=__builtin_amdgcn_exp2f(P0[r]); }while(0)
  #define RESC() do{ if(resc){ asm volatile("s_waitcnt lgkmcnt(0)":::"memory"); \
      _Pragma("unroll") for(int d_=0;d_<4;++d_) _Pragma("unroll") for(int r=0;r<16;++r)o[d_][r]*=wsf[crow(r,hi)]; } }while(0)
  f32x16 pA0,pA1,pB0,pB1;
  int sl_prev=0,sl_cur=0,sl_next=SLOTB;
  #define ROT() do{sl_prev=sl_cur;sl_cur=sl_next;sl_next=(sl_next==(NSLOT-1)*SLOTB)?0:sl_next+SLOTB;}while(0)
  DMA_K(2,2*SLOTB);
  WAIT_BAR(4);
  qkt(pA0,pA1,Kbase,qr,negm,r32,hi);asm volatile("s_nop 15\n\ts_nop 7":"+v"(pA0),"+v"(pA1));CMASK(pA0,pA1,0);
  START(pA0,pA1);
  _Pragma("unroll") for(int r=0;r<16;++r)pA1[r]=__builtin_amdgcn_exp2f(pA1[r]);
  WAIT_BAR(0);
  DMA_K(3,0);DMA_V(1,SLOTB);
  ROT();
  kload8(kf,kp0+sl_cur);
  WAIT_BAR(3);
  s16x4 vlo[8],vhi[8]; u32x4 pw0,pw1,pw2,pw3;
  #define PKW(P,B) cvtpk_s(P[B],P[B+1])
  #define PAF(k) __builtin_bit_cast(bf16x8,pw##k)
  #define VFR(i) (bf16x8){vlo[i][0],vlo[i][1],vlo[i][2],vlo[i][3],vhi[i][0],vhi[i][1],vhi[i][2],vhi[i][3]}
  #define PIN(x) asm volatile("":"+v"(x))
  #define MX3(a,b,c) __builtin_fmaxf(__builtin_fmaxf((a),(b)),(c))
  #define GAPA(MF,A0,A1,A2,A3,W0,W1,PW) do{ MF; sacc+=A0; sacc+=A1; sacc+=A2; sacc+=A3; PIN(sacc); W0; W1; PIN(PW); SBAR(); }while(0)
  #define EX(v) __builtin_amdgcn_exp2f(v)
  #define GAPB(MF,X,B,RL) do{ MF; X[B]=EX(X[B]); X[B+1]=EX(X[B+1]); RL; PIN(X); SBAR(); }while(0)
  #define VRD(i) do{ vlo[i]=vtr(vp_+(((i)>>2)*4096+((i)&3)*1024)); vhi[i]=vtr(vp_+(((i)>>2)*4096+((i)&3)*1024+512)); }while(0)
  #define VRDH(i) do{ vlo[i]=vtr(vp_+((((i)>>2)+2)*4096+((i)&3)*1024)); vhi[i]=vtr(vp_+((((i)>>2)+2)*4096+((i)&3)*1024+512)); }while(0)
  #define NORL do{}while(0)
  #define KRD(G,j) do{ if(G){ kload2(kf,kp0+sl_next,j); SBAR(); } }while(0)
  #define STEP(C0,C1,P0,P1,t,GK,GV,GL) do{ SBAR(); \
    const lds_cptr vp_=vp0+2*sl_prev; \
    float sacc=(P0[0]+P0[1]); \
    GAPA(C0=__builtin_amdgcn_mfma_f32_32x32x16_bf16(kf[0],qr[0],negm,0,0,0), P0[2],P0[3],P0[4],P0[5],     pw0[0]=PKW(P0,0), pw0[1]=PKW(P0,2), pw0); \
    GAPA(C1=__builtin_amdgcn_mfma_f32_32x32x16_bf16(kf[1],qr[0],negm,0,0,0), P0[6],P0[7],P0[8],P0[9],     pw0[2]=PKW(P0,4), pw0[3]=PKW(P0,6), pw0); \
    GAPA(C0=__builtin_amdgcn_mfma_f32_32x32x16_bf16(kf[2],qr[1],C0,0,0,0),   P0[10],P0[11],P0[12],P0[13], pw1[0]=PKW(P0,8), pw1[1]=PKW(P0,10), pw1); \
    GAPA(C1=__builtin_amdgcn_mfma_f32_32x32x16_bf16(kf[3],qr[1],C1,0,0,0),   P0[14],P0[15],P1[0],P1[1],   pw1[2]=PKW(P0,12),pw1[3]=PKW(P0,14), pw1); \
    GAPA(C0=__builtin_amdgcn_mfma_f32_32x32x16_bf16(kf[4],qr[2],C0,0,0,0),   P1[2],P1[3],P1[4],P1[5],     pw2[0]=PKW(P1,0), pw2[1]=PKW(P1,2), pw2); \
    GAPA(C1=__builtin_amdgcn_mfma_f32_32x32x16_bf16(kf[5],qr[2],C1,0,0,0),   P1[6],P1[7],P1[8],P1[9],     pw2[2]=PKW(P1,4), pw2[3]=PKW(P1,6), pw2); \
    GAPA(C0=__builtin_amdgcn_mfma_f32_32x32x16_bf16(kf[6],qr[3],C0,0,0,0),   P1[10],P1[11],P1[12],P1[13], pw3[0]=PKW(P1,8), pw3[1]=PKW(P1,10), pw3); \
    GAPA(C1=__builtin_amdgcn_mfma_f32_32x32x16_bf16(kf[7],qr[3],C1,0,0,0),   P1[14],P1[15],0.f,0.f,       pw3[2]=PKW(P1,12),pw3[3]=PKW(P1,14), pw3); \
    l_reg+=sacc; \
    VRD(0);VRD(4);VRD(1);VRD(5); SBAR(); VRD(2);VRD(6);VRD(3);VRD(7); SBAR();     \
    if(GK){DMA_K((t)+3,sl_cur);} if(GV){DMA_V((t)+1,sl_next);} \
    { float a=MX3(C0[0],C0[1],C1[0]),b=MX3(C0[2],C0[3],C1[1]); a=MX3(a,C1[2],C1[3]); \
      _Pragma("unroll") for(int r=4;r<16;r+=4){a=MX3(a,C0[r],C0[r+1]);b=MX3(b,C0[r+2],C0[r+3]);a=MX3(a,C1[r],C1[r+1]);b=MX3(b,C1[r+2],C1[r+3]);} \
      float rm=__builtin_fmaxf(a,b); { auto rr=__builtin_amdgcn_permlane32_swap(__float_as_uint(rm),__float_as_uint(rm),false,false); rm=__builtin_fmaxf(__uint_as_float(rr[0]),__uint_as_float(rr[1])); } \
      resc=false; \
      if(__builtin_expect(__any(rm>(float)THRL),0)){ const float dl=__builtin_fmaxf(rm,0.f); mhat+=dl; \
        _Pragma("unroll") for(int r=0;r<16;++r){C0[r]-=dl;C1[r]-=dl;} \
        _Pragma("unroll") for(int r=0;r<16;++r)negm[r]=-mhat; asm volatile("":"+v"(negm)); \
        const float f=__builtin_amdgcn_exp2f(-dl); l_reg*=f; if(hi==0)wsf[r32]=f; resc=true; } } \
    SBAR(); \
    GAPB(o[0]=__builtin_amdgcn_mfma_f32_32x32x16_bf16(PAF(0),VFR(0),o[0],0,0,0), C0,0,  VRDH(0)); \
    GAPB(o[1]=__builtin_amdgcn_mfma_f32_32x32x16_bf16(PAF(0),VFR(4),o[1],0,0,0), C0,2,  VRDH(4)); \
    GAPB(o[0]=__builtin_amdgcn_mfma_f32_32x32x16_bf16(PAF(1),VFR(1),o[0],0,0,0), C0,4,  VRDH(1)); \
    GAPB(o[1]=__builtin_amdgcn_mfma_f32_32x32x16_bf16(PAF(1),VFR(5),o[1],0,0,0), C0,6,  VRDH(5)); \
    GAPB(o[0]=__builtin_amdgcn_mfma_f32_32x32x16_bf16(PAF(2),VFR(2),o[0],0,0,0), C0,8,  VRDH(2)); \
    GAPB(o[1]=__builtin_amdgcn_mfma_f32_32x32x16_bf16(PAF(2),VFR(6),o[1],0,0,0), C0,10, VRDH(6)); \
    GAPB(o[0]=__builtin_amdgcn_mfma_f32_32x32x16_bf16(PAF(3),VFR(3),o[0],0,0,0), C0,12, VRDH(3)); \
    GAPB(o[1]=__builtin_amdgcn_mfma_f32_32x32x16_bf16(PAF(3),VFR(7),o[1],0,0,0), C0,14, VRDH(7)); \
    GAPB(o[2]=__builtin_amdgcn_mfma_f32_32x32x16_bf16(PAF(0),VFR(0),o[2],0,0,0), C1,0,  NORL); \
    GAPB(o[3]=__builtin_amdgcn_mfma_f32_32x32x16_bf16(PAF(0),VFR(4),o[3],0,0,0), C1,2,  NORL); \
    KRD(GL,0); GAPB(o[2]=__builtin_amdgcn_mfma_f32_32x32x16_bf16(PAF(1),VFR(1),o[2],0,0,0), C1,4,  NORL); \
    KRD(GL,1); GAPB(o[3]=__builtin_amdgcn_mfma_f32_32x32x16_bf16(PAF(1),VFR(5),o[3],0,0,0), C1,6,  NORL); \
    KRD(GL,2); GAPB(o[2]=__builtin_amdgcn_mfma_f32_32x32x16_bf16(PAF(2),VFR(2),o[2],0,0,0), C1,8,  NORL); \
    KRD(GL,3); GAPB(o[3]=__builtin_amdgcn_mfma_f32_32x32x16_bf16(PAF(2),VFR(6),o[3],0,0,0), C1,10, NORL); \
    GAPB(o[2]=__builtin_amdgcn_mfma_f32_32x32x16_bf16(PAF(3),VFR(3),o[2],0,0,0), C1,12, NORL); \
    GAPB(o[3]=__builtin_amdgcn_mfma_f32_32x32x16_bf16(PAF(3),VFR(7),o[3],0,0,0), C1,14, NORL); \
    }while(0)
  int t=1;
  #undef CMASK
  #define CMASK(P0,P1,t) do{}while(0)
  for(;t+5<NT;t+=2){
    STEP(pB0,pB1,pA0,pA1,t,true,true,true);     WAIT_BAR(3); RESC(); ROT();
    STEP(pA0,pA1,pB0,pB1,t+1,true,true,true);   WAIT_BAR(3); RESC(); ROT();
  }
  #undef CMASK
  #define CMASK(P0,P1,t) do{}while(0)
  #define ENDW(tt) do{ if((tt)+3<NT){WAIT_BAR(3);} else if((tt)+2<NT){WAIT_BAR(2);} else {WAIT_BAR(0);} }while(0)
  for(;t+1<NT;t+=2){
    STEP(pB0,pB1,pA0,pA1,t,(t+3<NT),(t+1<NT),(t+1<NT));       ENDW(t);   RESC(); ROT();
    STEP(pA0,pA1,pB0,pB1,t+1,(t+4<NT),(t+2<NT),(t+2<NT));     ENDW(t+1); RESC(); ROT();
  }
  STEP(pB0,pB1,pA0,pA1,NT-1,false,false,false); RESC();
  { float sacc=pB0[0]+pB0[1]; _Pragma("unroll") for(int r=2;r<16;++r)sacc+=pB0[r]; _Pragma("unroll") for(int r=0;r<16;++r)sacc+=pB1[r]; l_reg+=sacc;
    pw0=(u32x4){PKW(pB0,0),PKW(pB0,2),PKW(pB0,4),PKW(pB0,6)};pw1=(u32x4){PKW(pB0,8),PKW(pB0,10),PKW(pB0,12),PKW(pB0,14)};pw2=(u32x4){PKW(pB1,0),PKW(pB1,2),PKW(pB1,4),PKW(pB1,6)};pw3=(u32x4){PKW(pB1,8),PKW(pB1,10),PKW(pB1,12),PKW(pB1,14)};
    SBAR(); { const int vb0=(int)(unsigned)(size_t)vp0; pv(o,vb0+2*sl_cur,PAF(0),PAF(1),PAF(2),PAF(3)); pv(o+2,vb0+2*sl_cur+8192,PAF(0),PAF(1),PAF(2),PAF(3)); } }
  #undef PKW
  #undef PAF
  #undef VFR
  #undef PIN
  #undef MX3
  #undef GAPA
  #undef GAPB
  #undef EX
  #undef VRD
  #undef VRDH
  #undef NORL
  #undef KRD
  #undef STEP
  #undef ENDW
  {auto rr=__builtin_amdgcn_permlane32_swap(__float_as_uint(l_reg),__float_as_uint(l_reg),false,false);l_reg=__uint_as_float(rr[0])+__uint_as_float(rr[1]);}
  if(hi==0)wsf[32+r32]=l_reg;asm volatile("s_waitcnt lgkmcnt(0)":::"memory");
  float rli[16];
  #pragma unroll
  for(int r=0;r<16;++r)rli[r]=__builtin_amdgcn_rcpf(wsf[32+crow(r,hi)]);
  bf16*Ow=Oblk+(long)wid*QBLK*PO;
  if constexpr(MODE==0)
  { bf16*stg=(bf16*)(shm+LDS_OST8)+wid*2048;
    #pragma unroll
    for(int h2=0;h2<2;++h2){
      #pragma unroll
      for(int r=0;r<16;++r){const int orow=crow(r,hi);
        #pragma unroll
        for(int d0=0;d0<2;++d0)stg[orow*64+d0*32+r32]=__float2bfloat16(o[2*h2+d0][r]*rli[r]);}
      asm volatile("s_waitcnt lgkmcnt(0)":::"memory");
      #pragma unroll
      for(int i=0;i<4;++i){const int row=i*8+(lane>>3),ch=lane&7; const u32x4 v=*(const u32x4*)(stg+row*64+ch*8); ATTN_STORE16(Ow+(long)row*PO+h2*64+ch*8,v);}
      asm volatile("s_waitcnt lgkmcnt(0)":::"memory");
    } }
  else {
    bf16*stg=(bf16*)(shm+LDS_OST8)+wid*4096;
    #pragma unroll
    for(int r=0;r<16;++r){const int orow=crow(r,hi);
      #pragma unroll
      for(int d0=0;d0<4;++d0)stg[orow*128+d0*32+r32]=__float2bfloat16(o[d0][r]*rli[r]);}
    asm volatile("s_waitcnt lgkmcnt(0)":::"memory");
    const int row=lane>>1,hf=lane&1;
    const bf16*O1w=O1blk+((long)wid*QBLK+row)*PO+hf*64; bf16*AOw=AOblk+((long)wid*QBLK+row)*1024+hf*64;
    u32x4 a2[8],a1[8];
    #pragma unroll
    for(int i=0;i<8;++i){a2[i]=*(const u32x4*)(stg+row*128+hf*64+i*8); a1[i]=*(const u32x4*)(O1w+i*8);}
    float x[64]; float ss=0.f;
    #pragma unroll
    for(int i=0;i<8;++i){
      #pragma unroll
      for(int c=0;c<4;++c){const unsigned u1=a1[i][c],u2=a2[i][c];
        const float lo=__uint_as_float(u1<<16)-lam*__uint_as_float(u2<<16), hi2=__uint_as_float(u1&0xffff0000u)-lam*__uint_as_float(u2&0xffff0000u);
        x[i*8+2*c]=lo; x[i*8+2*c+1]=hi2; ss+=lo*lo+hi2*hi2;}}
    ss+=__shfl_xor(ss,1);
    const float rstd=1.f/sqrtf(ss*(1.f/128.f)+1e-6f)*omli;
    #pragma unroll
    for(int i=0;i<8;++i){ const f32x4_t s0=*(const f32x4_t*)(sln+hf*64+i*8), s1=*(const f32x4_t*)(sln+hf*64+i*8+4);
      u32x4 w; w[0]=cvtpk_s(x[i*8]*rstd*s0[0],x[i*8+1]*rstd*s0[1]); w[1]=cvtpk_s(x[i*8+2]*rstd*s0[2],x[i*8+3]*rstd*s0[3]);
      w[2]=cvtpk_s(x[i*8+4]*rstd*s1[0],x[i*8+5]*rstd*s1[1]); w[3]=cvtpk_s(x[i*8+6]*rstd*s1[2],x[i*8+7]*rstd*s1[3]);
      ATTN_STORE16(AOw+i*8,w);}
    asm volatile("s_waitcnt lgkmcnt(0)":::"memory");
  }
  asm volatile("s_waitcnt lgkmcnt(0)\n\ts_barrier":::"memory");
  #undef DMA_K
  #undef DMA_V
  #undef CMASK
  #undef START
  #undef RESC
  #undef ROT
}
constexpr int ATTN_LDS_BYTES=LDS_BYTES;
#undef SBAR
#undef WAIT_BAR
}
#define GAS __attribute__((address_space(1)))
#define LAS __attribute__((address_space(3)))
typedef unsigned short bfu;
typedef unsigned v4u __attribute__((ext_vector_type(4)));
typedef unsigned v2u __attribute__((ext_vector_type(2)));
typedef float f32x4 __attribute__((ext_vector_type(4)));
typedef float f32x16 __attribute__((ext_vector_type(16)));
typedef short bf16x8 __attribute__((ext_vector_type(8)));
#define LDS_WAIT() asm volatile("s_waitcnt lgkmcnt(0)" ::: "memory")
#define DI __device__ __forceinline__

#define XB_TMO      128
#define XB_XCNT(j)  (256  + 64 * (j))
#define XB_XSUB(j)  (1280 + 64 * (j))
#define XB_XGEN(j)  (2304 + 64 * (j))
#define XB_TOP      3328
#define XB_TOPGEN   3392
#define XCD_BAR_WORDS 3456
#define XB_SPIN_CAP (1u << 18)

__device__ __forceinline__ unsigned xb_ld(unsigned* p)              { return __hip_atomic_load(p, __ATOMIC_RELAXED, __HIP_MEMORY_SCOPE_AGENT); }
__device__ __forceinline__ unsigned xb_add(unsigned* p, unsigned v) { return __hip_atomic_fetch_add(p, v, __ATOMIC_RELAXED, __HIP_MEMORY_SCOPE_AGENT); }
__device__ __forceinline__ unsigned xb_xcc_id() { return (unsigned)__builtin_amdgcn_s_getreg((3 << 11) | 20) & 0xFu; }
#define XB_SPIN(cond, bar) do { unsigned _sp = 0; while (cond) { __builtin_amdgcn_s_sleep(1); \
    if ((++_sp & 255u) == 0u) { if (xb_ld(&(bar)[XB_TMO])) break; if (_sp > XB_SPIN_CAP) { atomicAdd(&(bar)[XB_TMO], 1u); break; } } } } while (0)

struct XcdBarrier {
    unsigned* bar; unsigned x;
    volatile LAS unsigned* st;
};

__device__ __forceinline__ XcdBarrier xcd_barrier_post(unsigned* bar, volatile LAS unsigned* st) {
    XcdBarrier b; b.bar = bar; b.x = xb_xcc_id(); b.st = st;
    if (threadIdx.x == 0) (void)xb_add(&bar[XB_XCNT(b.x)], 1u);
    return b;
}
__device__ __forceinline__ void xcd_barrier_complete(unsigned* bar, unsigned x, unsigned& nloc, unsigned& nx) {
    const unsigned G = gridDim.x * gridDim.y * gridDim.z;
    unsigned sum, cnt, mine, sp = 0u;
    for (;;) {
        sum = 0u; cnt = 0u; mine = 0u;
#pragma unroll
        for (unsigned j = 0; j < 16; ++j) { const unsigned c = xb_ld(&bar[XB_XCNT(j)]); sum += c; cnt += (c > 0u) ? 1u : 0u; mine = (j == x) ? c : mine; }
        if (sum == G) break;
        __builtin_amdgcn_s_sleep(1);
        if ((++sp & 255u) == 0u) { if (xb_ld(&bar[XB_TMO])) break; if (sp > XB_SPIN_CAP) { atomicAdd(&bar[XB_TMO], 1u); break; } }
    }
    nloc = mine > 0u ? mine : 1u; nx = cnt > 0u ? cnt : 1u;
}

__device__ __forceinline__ void xcd_barrier(const XcdBarrier& b) {
    asm volatile("s_waitcnt vmcnt(0)" ::: "memory");
    __syncthreads();
    if (threadIdx.x == 0) {
        unsigned* bar = b.bar;
        __builtin_amdgcn_s_waitcnt(0);
        unsigned nloc = b.st[0], nx = b.st[1];
        if (nloc == 0u) { xcd_barrier_complete(bar, b.x, nloc, nx); b.st[0] = nloc; b.st[1] = nx; }
        const unsigned old = xb_add(&bar[XB_XSUB(b.x)], 1u);
        const unsigned gen = old / nloc;
        if (old + 1u == (gen + 1u) * nloc) {
            __builtin_amdgcn_fence(__ATOMIC_RELEASE, "agent");
            asm volatile("s_waitcnt vmcnt(0)" ::: "memory");
            const unsigned og = xb_add(&bar[XB_TOP], 1u);
            const unsigned tg = og / nx;
            if (og + 1u == (tg + 1u) * nx) xb_add(&bar[XB_TOPGEN], 1u);
            else XB_SPIN(xb_ld(&bar[XB_TOPGEN]) == tg, bar);
            __builtin_amdgcn_fence(__ATOMIC_ACQUIRE, "agent");
            xb_add(&bar[XB_XGEN(b.x)], 1u);
            asm volatile("s_waitcnt vmcnt(0)" ::: "memory");
        } else {
            XB_SPIN(xb_ld(&bar[XB_XGEN(b.x)]) == gen, bar);
            __builtin_amdgcn_fence(__ATOMIC_ACQUIRE, "agent");
            asm volatile("s_waitcnt vmcnt(0)" ::: "memory");
        }
    }
    __syncthreads();
}


constexpr int DM = 1024, NBATCH = 2, SEQ = 16384, CTXL = 256, SEGR = SEQ + CTXL, MROWS = NBATCH * SEGR;
constexpr int FFN = 2816, NQKV = 2304, NAO = 1536, NMOD = 6 * DM;
constexpr float EPS = 1e-6f;
constexpr int NWAVES = 8, NTHR = 512;
constexpr int LDS_BYTES = 147456;
constexpr size_t MiB = 1u << 20;
constexpr size_t WS_MODS = 0;
constexpr size_t WS_BAR = 512 * 1024, BAR_BYTES = 16384;
constexpr size_t WS_CTXX = 1 * MiB;
constexpr size_t WS_RSTD = 29 * MiB;
constexpr size_t WS_WMIXA = 4 * MiB, WS_WMIXB = 4 * MiB + 4608 * 1024, WS_WMIXS = 4 * MiB + 6656 * 1024;
constexpr size_t WS_WUP = 12 * MiB, WS_WDN = 23 * MiB;
constexpr size_t WS_H = 32 * MiB;
constexpr size_t WS_BIG = 98 * MiB;
constexpr size_t WS_QKV = WS_BIG, WS_AORAW = WS_BIG + 147 * MiB, WS_AO = WS_BIG + 245 * MiB;
constexpr size_t WS_UV = WS_BIG, WS_S = WS_BIG + 131 * MiB;
constexpr size_t WS_ZB = WS_BIG, WS_ACT = WS_BIG + 179 * MiB;
constexpr size_t WS_END = 456 * MiB;

DI unsigned f2bf(float f) { unsigned u = __builtin_bit_cast(unsigned, f); return (u + 0x7fffu + ((u >> 16) & 1u)) >> 16; }
typedef float f32x2_h __attribute__((ext_vector_type(2))); typedef __bf16 bf16x2_h __attribute__((ext_vector_type(2)));
DI unsigned pk2(float lo, float hi) { const f32x2_h v = {lo, hi}; return __builtin_bit_cast(unsigned, __builtin_convertvector(v, bf16x2_h)); }
DI float bflo(unsigned u) { return __builtin_bit_cast(float, u << 16); }
DI float bfhi(unsigned u) { return __builtin_bit_cast(float, u & 0xffff0000u); }
DI float wave_sum(float v) {
#pragma unroll
    for (int o = 1; o < 64; o <<= 1) v += __shfl_xor(v, o);
    return v;
}
DI float half_sum(float v) {
#pragma unroll
    for (int o = 1; o < 32; o <<= 1) v += __shfl_xor(v, o);
    return v;
}
DI float silu_f(float x) { return x * __builtin_amdgcn_rcpf(1.f + __builtin_amdgcn_exp2f(x * -1.4426950408889634f)); }
DI int opaque_tid() { int t = threadIdx.x; asm volatile("" : "+v"(t)); return t; }
#define PHASE_IDS() const int tid = opaque_tid(), lane = tid & 63, wave = __builtin_amdgcn_readfirstlane(tid >> 6), gw = bx * NWAVES + wave, ngw = G * NWAVES; (void)lane; (void)gw; (void)ngw; (void)wave

struct EpiResid {
    static constexpr bool PERM = false, AFTER_DRAIN = false;
    const float* slat; const float* sctx; float* xlat; float* xctx; const float* gate;
    DI void operator()(const pg8::f32x4 (&acc)[2][2][4][2], const pg8::Unit& u, int wr, int wc, int fr, int fq) const {
        const int b = u.pm / 65, pp = u.pm % 65;
        const size_t boff = (pp == 0) ? (size_t)(b * CTXL) * DM : ((size_t)b * SEQ + (size_t)(pp - 1) * 256) * DM;
        float* base = ((pp == 0) ? xctx : xlat) + boff; const float* sbase = ((pp == 0) ? sctx : slat) + boff;
        const float* gt = gate + ((pp == 0) ? 2 : b) * NMOD;
        const int row0 = wr * 64 + fr, col0 = u.pn * 256 + wc * 32 + 4 * fq;
        pg8::f32x4 gv[2][2];
#pragma unroll
        for (int bj = 0; bj < 2; ++bj)
#pragma unroll
            for (int n = 0; n < 2; ++n) gv[bj][n] = *(const pg8::f32x4*)(gt + col0 + bj * 128 + n * 16);
#pragma unroll
        for (int ai = 0; ai < 2; ++ai) {
            pg8::f32x4 xv[4][2][2];
#pragma unroll
            for (int m = 0; m < 4; ++m) { const float* srow = sbase + (size_t)(row0 + ai * 128 + m * 16) * DM + col0;
#pragma unroll
                for (int bj = 0; bj < 2; ++bj)
#pragma unroll
                    for (int n = 0; n < 2; ++n) xv[m][bj][n] = *(const pg8::f32x4*)(srow + bj * 128 + n * 16); }
#pragma unroll
            for (int m = 0; m < 4; ++m) { float* rowp = base + (size_t)(row0 + ai * 128 + m * 16) * DM + col0;
#pragma unroll
                for (int bj = 0; bj < 2; ++bj)
#pragma unroll
                    for (int n = 0; n < 2; ++n) *(pg8::f32x4*)(rowp + bj * 128 + n * 16) = xv[m][bj][n] + gv[bj][n] * acc[ai][bj][m][n]; }
        }
    }
};
struct EpiGeluV {
    static constexpr bool PERM = true, AFTER_DRAIN = false;
    bfu* O; float* part;
    DI void operator()(const pg8::f32x4 (&acc)[2][2][4][2], const pg8::Unit& u, int wr, int wc, int fr, int fq) const {
        const int row0 = u.pm * 256 + wr * 64 + fr, col0 = u.pn * 256 + wc * 32 + 8 * fq;
        const bool isv = u.pn >= 4;
#pragma unroll
        for (int ai = 0; ai < 2; ++ai)
#pragma unroll
            for (int m = 0; m < 4; ++m) { const int row = row0 + ai * 128 + m * 16; bfu* rowp = O + (size_t)row * 2048 + col0; float ss = 0.f;
#pragma unroll
                for (int bj = 0; bj < 2; ++bj) { const pg8::f32x4 v0 = acc[ai][bj][m][0], v1 = acc[ai][bj][m][1];
                    const pg8::f32x2 a = pg8::gelu_pk((pg8::f32x2){v0[0], v0[1]}), b = pg8::gelu_pk((pg8::f32x2){v0[2], v0[3]}), c = pg8::gelu_pk((pg8::f32x2){v1[0], v1[1]}), d = pg8::gelu_pk((pg8::f32x2){v1[2], v1[3]});
                    ss += (a.x * a.x + a.y * a.y) + (b.x * b.x + b.y * b.y) + (c.x * c.x + c.y * c.y) + (d.x * d.x + d.y * d.y);
                    pg8::u32x4 w; w.x = pg8::cvt_pk_bf16(a.x, a.y); w.y = pg8::cvt_pk_bf16(b.x, b.y); w.z = pg8::cvt_pk_bf16(c.x, c.y); w.w = pg8::cvt_pk_bf16(d.x, d.y);
                    *(pg8::u32x4*)(rowp + bj * 128) = w; }
                if (isv) { ss += __shfl_xor(ss, 16); ss += __shfl_xor(ss, 32); if (fq == 0) part[(size_t)row * 16 + (u.pn - 4) * 4 + wc] = ss; }
            }
    }
};
DI float dpp_prev(float x) { return __builtin_bit_cast(float, __builtin_amdgcn_update_dpp(0, __builtin_bit_cast(int, x), 0x111, 0xf, 0xf, true)); }
DI float dpp_next(float x) { return __builtin_bit_cast(float, __builtin_amdgcn_update_dpp(0, __builtin_bit_cast(int, x), 0x101, 0xf, 0xf, true)); }
struct EpiConv {
    static constexpr bool PERM = true, AFTER_DRAIN = false;
    bfu* ACT; bfu* ZB; const float* cw; const float* cb;
    DI void operator()(const pg8::f32x4 (&acc)[2][2][4][2], const pg8::Unit& u, int wr, int wc, int fr, int fq) const {
        const int row0 = u.pm * 256 + wr * 64 + fr;
        const bool edge = (fr < 2) || (fr >= 14); const int eidx = (fr < 2) ? fr : fr - 12;
        const int jt = wc * 32 + 8 * fq, j = u.pn * 128 + jt;
        pg8::f32x4 g0[2], g1[2], g2[2], gb[2], u0[2], u1[2], u2[2], ub[2];
#pragma unroll
        for (int n = 0; n < 2; ++n) { const int jj = j + 4 * n;
            g0[n] = *(const pg8::f32x4*)(cw + jj); g1[n] = *(const pg8::f32x4*)(cw + 2 * FFN + jj); g2[n] = *(const pg8::f32x4*)(cw + 4 * FFN + jj); gb[n] = *(const pg8::f32x4*)(cb + jj);
            u0[n] = *(const pg8::f32x4*)(cw + FFN + jj); u1[n] = *(const pg8::f32x4*)(cw + 3 * FFN + jj); u2[n] = *(const pg8::f32x4*)(cw + 5 * FFN + jj); ub[n] = *(const pg8::f32x4*)(cb + FFN + jj); }
#pragma unroll
        for (int ai = 0; ai < 2; ++ai)
#pragma unroll
            for (int m = 0; m < 4; ++m) {
                const int row = row0 + ai * 128 + m * 16;
                v4u o, za, zb4;
#pragma unroll
                for (int n = 0; n < 2; ++n) {
                    const pg8::f32x4 zg = acc[ai][0][m][n], zu = acc[ai][1][m][n];
                    pg8::f32x4 pg, ng, pu, nu;
#pragma unroll
                    for (int i = 0; i < 4; ++i) { pg[i] = dpp_prev(zg[i]); ng[i] = dpp_next(zg[i]); pu[i] = dpp_prev(zu[i]); nu[i] = dpp_next(zu[i]); }
                    const pg8::f32x4 cg = g0[n] * pg + g1[n] * zg + g2[n] * ng + gb[n], cu = u0[n] * pu + u1[n] * zu + u2[n] * nu + ub[n];
                    o[2 * n] = pk2(silu_f(cg[0]) * cu[0], silu_f(cg[1]) * cu[1]); o[2 * n + 1] = pk2(silu_f(cg[2]) * cu[2], silu_f(cg[3]) * cu[3]);
                    za[2 * n] = pk2(zg[0], zg[1]); za[2 * n + 1] = pk2(zg[2], zg[3]); zb4[2 * n] = pk2(zu[0], zu[1]); zb4[2 * n + 1] = pk2(zu[2], zu[3]);
                }
                *(v4u*)(ACT + (size_t)row * FFN + j) = o;
                if (edge) { bfu* zb = ZB + ((size_t)(row >> 4) * 4 + eidx) * (2 * FFN) + u.pn * 256 + jt; *(v4u*)zb = za; *(v4u*)(zb + 128) = zb4; }
            }
    }
};
struct RowSched {
    pg8::StaticOrder so; int skip;
    DI void init(int N, int G, int c, int skip_ctx) { so.init(skip_ctx ? NBATCH * SEQ : MROWS, N, G, c); skip = skip_ctx; }
    DI bool next(int i, pg8::Unit& u) const { if (!so.next(i, u)) return false; if (skip) u.pm = (u.pm >> 6) * 65 + 1 + (u.pm & 63); return true; }
    DI void a_ready(const pg8::Unit&) const {}
    DI void done(const pg8::Unit&) const {}
};

template <int NB  > DI void p_ctx_resid(const bfu* A, int K, const bfu* Wt, const float* xsrc, float* xdst, const float* gate, LAS unsigned char* lds, int bx, int G) {
    PHASE_IDS();
    const int r32 = lane & 31, hi = lane >> 5;
    LAS float* part = (LAS float*)lds;
    const int spw = K / 128;
    for (int blk = bx; blk < 256; blk += G) {
        const int rb = blk >> 4, cb = blk & 15, cr0 = rb * 32, c0 = cb * 64;
        const int cr = cr0 + r32, grow = (cr >> 8) * SEGR + (cr & 255);
        const bfu* ap = A + (size_t)grow * K + (size_t)wave * spw * 16 + 8 * hi;
        const bfu* bp0 = Wt + (size_t)(c0 + r32) * K + (size_t)wave * spw * 16 + 8 * hi;
        const bfu* bp1 = bp0 + (size_t)32 * K;
        f32x16 acc0 = f32x16{}, acc1 = f32x16{};
#pragma unroll 1
        for (int s0 = 0; s0 < spw; s0 += NB) {
            bf16x8 af[NB], b0[NB], b1[NB];
#pragma unroll
            for (int q = 0; q < NB; ++q) { af[q] = *(const bf16x8*)(ap + 16 * (s0 + q)); b0[q] = *(const bf16x8*)(bp0 + 16 * (s0 + q)); b1[q] = *(const bf16x8*)(bp1 + 16 * (s0 + q)); }
#pragma unroll
            for (int q = 0; q < NB; ++q) { acc0 = __builtin_amdgcn_mfma_f32_32x32x16_bf16(af[q], b0[q], acc0, 0, 0, 0); acc1 = __builtin_amdgcn_mfma_f32_32x32x16_bf16(af[q], b1[q], acc1, 0, 0, 0); }
        }
        LAS float* pw = part + ((wave * 2) * 64 + lane) * 16;
#pragma unroll
        for (int v = 0; v < 16; ++v) { pw[v] = acc0[v]; pw[64 * 16 + v] = acc1[v]; }
        __syncthreads();
        { const int e = tid * 4, j = e >> 10, ln = (e >> 4) & 63, v0 = e & 15;
          f32x4 s = *(const LAS f32x4*)(part + e);
#pragma unroll
          for (int w = 1; w < 8; ++w) s = s + *(const LAS f32x4*)(part + w * 2048 + e);
          const int col = c0 + 32 * j + (ln & 31); const float gt = gate[col];
#pragma unroll
          for (int q = 0; q < 4; ++q) { const int v = v0 + q, row = cr0 + (v & 3) + 8 * (v >> 2) + 4 * (ln >> 5);
              const size_t o = (size_t)row * DM + col; xdst[o] = xsrc[o] + gt * s[q]; } }
        __syncthreads();
    }
}

DI void transpose_item(const float* W, int K, int N, bfu* WT, int mode, LAS float* scr, int item, int lane) {
    const int nblk = N / 32, kb = item / nblk, nb = item % nblk, k0 = 64 * kb, n0 = 32 * nb;
    int orow0 = n0;
    if (mode == 1) { const int isu = n0 >= FFN, j0 = isu ? n0 - FFN : n0; orow0 = (j0 >> 7) * 256 + isu * 128 + (j0 & 127); }
#pragma unroll 8
    for (int i = 0; i < 32; ++i) { const int kk = 2 * i + (lane >> 5); scr[kk * 33 + (lane & 31)] = W[(size_t)(k0 + kk) * N + n0 + (lane & 31)]; }
    LDS_WAIT(); asm volatile("" ::: "memory");
    const int c = lane & 7;
#pragma unroll
    for (int j = 0; j < 4; ++j) { const int n = (lane >> 3) + 8 * j; const LAS float* s = scr + (8 * c) * 33 + n;
        v4u o; o.x = pk2(s[0 * 33], s[1 * 33]); o.y = pk2(s[2 * 33], s[3 * 33]); o.z = pk2(s[4 * 33], s[5 * 33]); o.w = pk2(s[6 * 33], s[7 * 33]);
        *(v4u*)(WT + (size_t)(orow0 + n) * K + k0 + 8 * c) = o; }
    LDS_WAIT(); asm volatile("" ::: "memory");
}
DI void convert_weights(const float* W, int K, int N, bfu* WT, int mode, LAS unsigned char* lds, int bx, int G) {
    PHASE_IDS();
    LAS float* scr = (LAS float*)(lds + wave * 16384);
    const int nitems = (K / 64) * (N / 32);
    for (int it = gw; it < nitems; it += ngw) transpose_item(W, K, N, WT, mode, scr, it, lane);
}

DI void p_mods(const float* c, const float* cctx, const float* ada_w, const float* ada_b, float* mods, LAS float* sl, int bx, int G) {
    PHASE_IDS();
    LAS float* part = sl + 3 * DM;
    for (int i = tid; i < 3 * DM; i += NTHR) { const float v = (i < 2 * DM) ? c[i] : cctx[i - 2 * DM]; sl[i] = silu_f(v); }
    __syncthreads();
    for (int it = bx; it < 4 * 96; it += G) {
        const int l = it / 96, jb = it % 96, j = jb * 64 + lane, k0 = wave * 128;
        const float* wp = ada_w + ((size_t)l * DM + k0) * NMOD + j;
        float a0 = 0.f, a1 = 0.f, a2 = 0.f;
#pragma unroll 8
        for (int k = 0; k < 128; ++k) { const float w = wp[(size_t)k * NMOD]; a0 += sl[k0 + k] * w; a1 += sl[DM + k0 + k] * w; a2 += sl[2 * DM + k0 + k] * w; }
        part[(wave * 3 + 0) * 64 + lane] = a0; part[(wave * 3 + 1) * 64 + lane] = a1; part[(wave * 3 + 2) * 64 + lane] = a2;
        __syncthreads();
        if (tid < 192) { const int wh = tid >> 6; float s = ada_b[l * NMOD + j];
#pragma unroll
            for (int q = 0; q < 8; ++q) s += part[(q * 3 + wh) * 64 + lane];
            mods[((size_t)l * 3 + wh) * NMOD + j] = s; }
        __syncthreads();
    }
}

DI float* xrow(float* xlat, float* xctx, int r, int& which, bool& isctx) {
    const int b = r / SEGR, p = r % SEGR; isctx = p < CTXL; which = isctx ? 2 : b;
    return isctx ? xctx + (size_t)(b * CTXL + p) * DM : xlat + ((size_t)b * SEQ + (p - CTXL)) * DM;
}

template <bool COPY>
DI void p_norm(const float* slat, const float* sctx, float* dlat, float* dctx, const float* w, const float* mods_l, int o_sh, int o_sc, bfu* H, bool do_ctx, int bx, int G) {
    PHASE_IDS();
    int cur = -1; f32x4 av[4], bv[4];
#pragma unroll
    for (int j = 0; j < 4; ++j) { av[j] = (f32x4){0.f, 0.f, 0.f, 0.f}; bv[j] = av[j]; }
    for (int r = gw; r < MROWS; r += ngw) {
        int which; bool isctx; const float* xr = xrow((float*)slat, (float*)sctx, r, which, isctx);
        if (isctx && !do_ctx) continue;
        const f32x4* x4 = (const f32x4*)xr + lane;
        f32x4 v[4]; float s = 0.f;
#pragma unroll
        for (int j = 0; j < 4; ++j) v[j] = x4[64 * j];
        if (which != cur) { cur = which; const float* md = mods_l + which * NMOD;
#pragma unroll
            for (int j = 0; j < 4; ++j) { const int c = 4 * (lane + 64 * j);
                const f32x4 wv = *(const f32x4*)(w + c), sc = *(const f32x4*)(md + o_sc + c); av[j] = wv * (sc + 1.f); bv[j] = *(const f32x4*)(md + o_sh + c); } }
#pragma unroll
        for (int j = 0; j < 4; ++j) s += (v[j].x * v[j].x + v[j].y * v[j].y) + (v[j].z * v[j].z + v[j].w * v[j].w);
        const float rstd = __builtin_amdgcn_rsqf(wave_sum(s) * (1.f / DM) + EPS);
        if (COPY) { int w2; bool c2; f32x4* d4 = (f32x4*)xrow(dlat, dctx, r, w2, c2) + lane;
#pragma unroll
            for (int j = 0; j < 4; ++j) d4[64 * j] = v[j]; }
        v2u* o8 = (v2u*)(H + (size_t)r * DM) + lane;
#pragma unroll
        for (int j = 0; j < 4; ++j) { const f32x4 y = v[j] * rstd * av[j] + bv[j];
            v2u o; o.x = pk2(y.x, y.y); o.y = pk2(y.z, y.w); o8[64 * j] = o; }
    }
}
DI void p_final(float* xlat, const float* w, int bx, int G) {
    PHASE_IDS();
    f32x4 wv4[4];
#pragma unroll
    for (int j = 0; j < 4; ++j) wv4[j] = *(const f32x4*)(w + 4 * (lane + 64 * j));
    for (int r = gw; r < NBATCH * SEQ; r += ngw) {
        f32x4* x4 = (f32x4*)(xlat + (size_t)r * DM) + lane;
        f32x4 v[4]; float s = 0.f;
#pragma unroll
        for (int j = 0; j < 4; ++j) { v[j] = x4[64 * j]; s += (v[j].x * v[j].x + v[j].y * v[j].y) + (v[j].z * v[j].z + v[j].w * v[j].w); }
        const float rstd = 1.f / sqrtf(wave_sum(s) * (1.f / DM) + EPS);
#pragma unroll
        for (int j = 0; j < 4; ++j) x4[64 * j] = v[j] * rstd * wv4[j];
    }
}

DI void p_qkvpost(bfu* QKV, const float* qnorm, const float* knorm, int bx, int G) {
    PHASE_IDS();
    const int i = lane & 31, hh = lane >> 5, fi = i & 15;
    const float inv = exp2f(-(float)fi * (13.287712379549449f / 16.f));
    const float C2 = 0.125f * 1.4426950408889634f;
    const float qn0 = qnorm[2 * i], qn1 = qnorm[2 * i + 1], kn0 = knorm[2 * i], kn1 = knorm[2 * i + 1];
    for (int r = gw; r < MROWS; r += ngw) {
        const int p = r % SEGR; const bool isctx = p < CTXL; const int t = p - CTXL;
        float cs = 1.f, sn = 0.f;
        if (!isctx) { const float pos = (float)((i < 16) ? (t >> 6) : (t & 63)); const float ang = pos * inv;
            const float k = rintf(ang * 0.15915494309189535f); float rr = fmaf(-k, 6.2831854820251465f, ang); rr = fmaf(-k, -1.7484555e-7f, rr);
            cs = cosf(rr); sn = sinf(rr); }
        bfu* row = QKV + (size_t)r * NQKV;
        unsigned uu[13];
#pragma unroll
        for (int it = 0; it < 13; ++it) { const int hs = 2 * it + hh;
            const int col0 = (hs < 16) ? hs * 64 : (hs < 24 ? 1536 + (hs - 16) * 64 : 2048 + (hs - 24) * 64);
            uu[it] = *((const unsigned*)(row + col0) + i); }
#pragma unroll
        for (int it = 0; it < 13; ++it) {
            const int hs = 2 * it + hh;
            const int col0 = (hs < 16) ? hs * 64 : (hs < 24 ? 1536 + (hs - 16) * 64 : 2048 + (hs - 24) * 64);
            float x0 = bflo(uu[it]), x1 = bfhi(uu[it]);
            if (it >= 8) { const float ss = half_sum(x0 * x0 + x1 * x1); const float rstd = 1.f / sqrtf(ss * (1.f / 64.f) + EPS);
                x0 *= rstd * ((it < 12) ? qn0 : kn0); x1 *= rstd * ((it < 12) ? qn1 : kn1); }
            float y0 = x0 * cs - x1 * sn, y1 = x0 * sn + x1 * cs;
            if (it < 4 || (it >= 8 && it < 12)) { y0 *= C2; y1 *= C2; }
            *((unsigned*)(row + col0) + i) = pk2(y0, y1);
        }
    }
}

DI void attn_pair(const bfu* QKV, bfu* AOR, bfu* AO, int b, int hd, size_t qrow_off, int NT, float lam, const float* subln, float omli, char* lds) {
    using abf = attn_body::bf16;
    const size_t rb = (size_t)b * SEGR, rq = rb + qrow_off;
    const bfu* V = QKV + rb * NQKV + 1024 + hd * 128; bfu* O1 = AOR + rq * NAO + hd * 256;
    attn_body::attn_unit128<8, 0>((const abf*)(QKV + rq * NQKV + hd * 64), (const abf*)(QKV + rb * NQKV + 512 + hd * 64), (const abf*)V, (abf*)O1, NT, lds, nullptr, nullptr, 0.f, nullptr, 0.f);
    attn_body::attn_unit128<8, 1>((const abf*)(QKV + rq * NQKV + 256 + hd * 64), (const abf*)(QKV + rb * NQKV + 768 + hd * 64), (const abf*)V, (abf*)O1, NT, lds, (const abf*)O1, (abf*)(AO + rq * DM + hd * 128), lam, subln, omli);
}
DI void attn_gqa(const bfu* QKV, bfu* AO, int b, int hq, size_t qrow_off, int NT, char* lds) {
    using abf = attn_body::bf16;
    const size_t rb = (size_t)b * SEGR, rq = rb + qrow_off; const int g = hq >> 2;
    attn_body::attn_unit<8>((const abf*)(QKV + rq * NQKV + 1536 + hq * 64), (const abf*)(QKV + rb * NQKV + 2048 + g * 64), (const abf*)(QKV + rb * NQKV + 2176 + g * 64), (abf*)(AO + rq * DM + 512 + hq * 64), DM, NT, lds);
}
DI void p_attn(const bfu* QKV, bfu* AOR, bfu* AO, const float* lq1, const float* lk1, const float* lq2, const float* lk2, const float* subln, float lam_init, bool ctx_out, char* lds, int bx, int G, int vcu, int xmap) {
    PHASE_IDS();
    const float lam = __expf(wave_sum(lq1[lane] * lk1[lane])) - __expf(wave_sum(lq2[lane] * lk2[lane])) + lam_init, omli = 1.f - lam_init;
    const int npair = 8 * 64 + (ctx_out ? 8 : 0), ngqa = 16 * 64 + (ctx_out ? 16 : 0);
    for (int i = 0;; ++i) {
        int u;
        if (xmap) { if (i >= 2) { u = 512 + (i - 2) * G + bx; if (u < 512 || i > 2 || !(u < npair)) break; } else u = (vcu >> 5) * 64 + i * 32 + (vcu & 31); }
        else { u = i * G + bx; if (u >= npair) break; }
        if (u < 512) attn_pair(QKV, AOR, AO, (u >> 6) >> 2, (u >> 6) & 3, CTXL + (size_t)(u & 63) * 256, SEGR / 64, lam, subln, omli, lds);
        else attn_pair(QKV, AOR, AO, (u - 512) >> 2, (u - 512) & 3, 0, CTXL / 64, lam, subln, omli, lds);
    }
    for (int i = 0;; ++i) {
        int u;
        if (xmap) { if (i >= 4) { u = 1024 + (i - 4) * G + bx; if (i > 4 || !(u < ngqa)) break; } else u = (2 * (vcu >> 5) + (i >> 1)) * 64 + (i & 1) * 32 + (vcu & 31); }
        else { u = i * G + bx; if (u >= ngqa) break; }
        if (u < 1024) attn_gqa(QKV, AO, (u >> 6) >> 3, (u >> 6) & 7, CTXL + (size_t)(u & 63) * 256, SEGR / 64, lds);
        else attn_gqa(QKV, AO, (u - 1024) >> 3, (u - 1024) & 7, 0, CTXL / 64, lds);
    }
}

DI void p_sgu_mix(const bfu* UV, const float* part, const float* vnorm, const bfu* Wsb, const float* bs, bfu* So, bool do_ctx, LAS unsigned char* lds, int bx, int G) {
    PHASE_IDS();
    const int w = wave, r32 = lane & 31, hi = lane >> 5;
    constexpr int VS = 264;
    LAS bfu* Vr = (LAS bfu*)lds; LAS float* rsl = (LAS float*)(lds + 69632);
    const int c8 = (tid & 31) * 8;
    int gcur = -1; bf16x8 afr[4][8];
    for (int it = bx; it < (MROWS / 128) * 4; it += G) {
        const int n = it >> 2, g = it & 3, R0 = n * 128, c0 = g * 256;
        if (!do_ctx && (R0 % SEGR) < CTXL) continue;
        const f32x4 n0 = *(const f32x4*)(vnorm + c0 + c8), n1 = *(const f32x4*)(vnorm + c0 + c8 + 4);
        v4u vin[8]; float rsv[8];
#pragma unroll
        for (int k = 0; k < 8; ++k) { const int q = (tid >> 5) + 16 * k; vin[k] = *(const v4u*)(UV + (size_t)(R0 + q) * 2048 + 1024 + c0 + c8); }
        if (tid < 128) { const f32x4* pp = (const f32x4*)(part + (size_t)(R0 + tid) * 16); const f32x4 p0 = pp[0], p1 = pp[1], p2 = pp[2], p3 = pp[3];
            float s = p0.x; s += p0.y; s += p0.z; s += p0.w; s += p1.x; s += p1.y; s += p1.z; s += p1.w; s += p2.x; s += p2.y; s += p2.z; s += p2.w; s += p3.x; s += p3.y; s += p3.z; s += p3.w;
            rsl[tid] = 1.f / sqrtf(s * (1.f / DM) + EPS); }
        __syncthreads();
#pragma unroll
        for (int k = 0; k < 8; ++k) rsv[k] = rsl[(tid >> 5) + 16 * k];
        if (g != gcur) { gcur = g; const bfu* Wg = Wsb + (size_t)g * 16384;
#pragma unroll
            for (int pb = 0; pb < 4; ++pb)
#pragma unroll
                for (int ks = 0; ks < 8; ++ks) afr[pb][ks] = *(const bf16x8*)(Wg + (32 * pb + r32) * 128 + 16 * ks + 8 * hi); }
#pragma unroll
        for (int k = 0; k < 8; ++k) { const int q = (tid >> 5) + 16 * k; const v4u u = vin[k]; const float rs = rsv[k];
            v4u o; o.x = pk2(bflo(u.x) * rs * n0.x, bfhi(u.x) * rs * n0.y); o.y = pk2(bflo(u.y) * rs * n0.z, bfhi(u.y) * rs * n0.w);
            o.z = pk2(bflo(u.z) * rs * n1.x, bfhi(u.z) * rs * n1.y); o.w = pk2(bflo(u.w) * rs * n1.z, bfhi(u.w) * rs * n1.w);
            *(LAS v4u*)(Vr + q * VS + c8) = o; }
        __syncthreads();
        f32x16 acc[4];
#pragma unroll
        for (int pb = 0; pb < 4; ++pb) acc[pb] = f32x16{};
        const int cl = 32 * w + r32;
#pragma unroll
        for (int ks = 0; ks < 8; ++ks) {
            const LAS bfu* vp = Vr + (16 * ks + 8 * hi) * VS + cl;
            v4u bw; bw.x = (unsigned)vp[0] | ((unsigned)vp[VS] << 16); bw.y = (unsigned)vp[2 * VS] | ((unsigned)vp[3 * VS] << 16);
            bw.z = (unsigned)vp[4 * VS] | ((unsigned)vp[5 * VS] << 16); bw.w = (unsigned)vp[6 * VS] | ((unsigned)vp[7 * VS] << 16);
            const bf16x8 bfr = __builtin_bit_cast(bf16x8, bw);
#pragma unroll
            for (int pb = 0; pb < 4; ++pb) acc[pb] = __builtin_amdgcn_mfma_f32_32x32x16_bf16(afr[pb][ks], bfr, acc[pb], 0, 0, 0);
        }
        const int c = c0 + cl;
#pragma unroll
        for (int pb = 0; pb < 4; ++pb) {
            unsigned short ur[16]; float bb[16];
#pragma unroll
            for (int v = 0; v < 16; ++v) { const int p = 32 * pb + (v & 3) + 8 * (v >> 2) + 4 * hi; ur[v] = UV[(size_t)(R0 + p) * 2048 + c]; bb[v] = bs[g * 128 + p]; }
#pragma unroll
            for (int v = 0; v < 16; ++v) { const int p = 32 * pb + (v & 3) + 8 * (v >> 2) + 4 * hi;
                const float uu = __builtin_bit_cast(float, (unsigned)ur[v] << 16);
                So[(size_t)(R0 + p) * DM + c] = (bfu)f2bf(uu * (acc[pb][v] + bb[v])); }
        }
        __syncthreads();
    }
}

DI void p_convfix(const bfu* ZB, bfu* ACT, const float* cw, const float* cb, bool do_ctx, int bx, int G) {
    PHASE_IDS();
    constexpr int CPR = FFN / 8;
    const int nitems = (MROWS / 16) * CPR;
    for (int it = bx * NTHR + tid; it < nitems; it += G * NTHR) {
        const int k = it / CPR, ch = it % CPR, j = ch * 8, pn = j >> 7, jt = j & 127;
        const int r0 = k * 16, p0 = r0 % SEGR;
        if (!do_ctx && p0 < CTXL) continue;
        const bool first = (p0 == 0) || (p0 == CTXL), last = (p0 + 16 == CTXL) || (p0 + 16 == SEGR);
        const bfu* zb = ZB + (size_t)k * 4 * (2 * FFN) + pn * 256 + jt;
        const v4u zero = (v4u){0u, 0u, 0u, 0u};
        v4u zg[6], zu[6];
        if (first) { zg[0] = zero; zu[0] = zero; } else { zg[0] = *(const v4u*)(zb - (2 * FFN)); zu[0] = *(const v4u*)(zb - (2 * FFN) + 128); }
#pragma unroll
        for (int q = 0; q < 4; ++q) { zg[1 + q] = *(const v4u*)(zb + (size_t)q * (2 * FFN)); zu[1 + q] = *(const v4u*)(zb + (size_t)q * (2 * FFN) + 128); }
        if (last) { zg[5] = zero; zu[5] = zero; } else { zg[5] = *(const v4u*)(zb + (size_t)4 * (2 * FFN)); zu[5] = *(const v4u*)(zb + (size_t)4 * (2 * FFN) + 128); }
        float wg[3][8], wu[3][8], bg[8], bu[8];
#pragma unroll
        for (int d = 0; d < 3; ++d) { const f32x4 a = *(const f32x4*)(cw + d * 2 * FFN + j), b = *(const f32x4*)(cw + d * 2 * FFN + j + 4), c = *(const f32x4*)(cw + d * 2 * FFN + FFN + j), e = *(const f32x4*)(cw + d * 2 * FFN + FFN + j + 4);
            wg[d][0] = a.x; wg[d][1] = a.y; wg[d][2] = a.z; wg[d][3] = a.w; wg[d][4] = b.x; wg[d][5] = b.y; wg[d][6] = b.z; wg[d][7] = b.w;
            wu[d][0] = c.x; wu[d][1] = c.y; wu[d][2] = c.z; wu[d][3] = c.w; wu[d][4] = e.x; wu[d][5] = e.y; wu[d][6] = e.z; wu[d][7] = e.w; }
        { const f32x4 a = *(const f32x4*)(cb + j), b = *(const f32x4*)(cb + j + 4), c = *(const f32x4*)(cb + FFN + j), e = *(const f32x4*)(cb + FFN + j + 4);
            bg[0] = a.x; bg[1] = a.y; bg[2] = a.z; bg[3] = a.w; bg[4] = b.x; bg[5] = b.y; bg[6] = b.z; bg[7] = b.w;
            bu[0] = c.x; bu[1] = c.y; bu[2] = c.z; bu[3] = c.w; bu[4] = e.x; bu[5] = e.y; bu[6] = e.z; bu[7] = e.w; }
#pragma unroll
        for (int s = 0; s < 2; ++s) {
            const v4u gp = zg[3 * s], gc = zg[3 * s + 1], gn = zg[3 * s + 2], up = zu[3 * s], uc = zu[3 * s + 1], un = zu[3 * s + 2];
            float o[8];
#define CV(kk, P, LOHI) { const float zgv = wg[0][kk] * LOHI(gp.P) + wg[1][kk] * LOHI(gc.P) + wg[2][kk] * LOHI(gn.P) + bg[kk]; \
                          const float zuv = wu[0][kk] * LOHI(up.P) + wu[1][kk] * LOHI(uc.P) + wu[2][kk] * LOHI(un.P) + bu[kk]; o[kk] = silu_f(zgv) * zuv; }
            CV(0, x, bflo) CV(1, x, bfhi) CV(2, y, bflo) CV(3, y, bfhi) CV(4, z, bflo) CV(5, z, bfhi) CV(6, w, bflo) CV(7, w, bfhi)
#undef CV
            v4u ov; ov.x = pk2(o[0], o[1]); ov.y = pk2(o[2], o[3]); ov.z = pk2(o[4], o[5]); ov.w = pk2(o[6], o[7]);
            *(v4u*)(ACT + (size_t)(r0 + 15 * s) * FFN + j) = ov;
        }
    }
}

struct Args { const float* in[27]; float* out; unsigned char* ws; };
enum { I_X = 0, I_C, I_CTX, I_CCTX, I_ADAW, I_ADAB, I_MIXN, I_FFNN, I_FINN, I_AWIN, I_AWOUT, I_LQ1, I_LK1, I_LQ2, I_LK2, I_SUBLN, I_QN, I_KN,
       I_SWIN, I_SVN, I_SWS, I_SBS, I_SWOUT, I_FUP, I_FCW, I_FCB, I_FDN };

#ifndef PROBE_ATTN
#define PROBE_ATTN 1
#endif
#ifndef PROBE_SYNC
#define PROBE_SYNC 1
#endif
#ifndef PROBE_GEMM
#define PROBE_GEMM 1
#endif
#ifndef PROBE_MISC
#define PROBE_MISC 1
#endif
#ifndef PROBE_CONV
#define PROBE_CONV 1
#endif
#ifndef PROBE_ELT
#define PROBE_ELT 1
#endif
#define GSYNC() do { for (int rs_ = 0; rs_ < PROBE_SYNC; ++rs_) xcd_barrier(xbar); } while (0)
#define ELT(x) do { for (int re_ = 0; re_ < PROBE_ELT; ++re_) { x; } } while (0)
__global__ void __launch_bounds__(NTHR, 2) fwd_megakernel(Args a) {
    extern __shared__ __attribute__((aligned(16))) unsigned char lds_raw[];
    cg::grid_group grid = cg::this_grid();
    LAS unsigned char* lds = (LAS unsigned char*)lds_raw;
    const int G = gridDim.x, bx = blockIdx.x;
    unsigned char* ws = a.ws;
    float* mods = (float*)(ws + WS_MODS); float* ctxx = (float*)(ws + WS_CTXX); float* rstd = (float*)(ws + WS_RSTD);
    bfu* wmixa = (bfu*)(ws + WS_WMIXA); bfu* wmixb = (bfu*)(ws + WS_WMIXB); bfu* wmixs = (bfu*)(ws + WS_WMIXS);
    bfu* wup = (bfu*)(ws + WS_WUP); bfu* wdn = (bfu*)(ws + WS_WDN);
    bfu* H = (bfu*)(ws + WS_H); bfu* QKV = (bfu*)(ws + WS_QKV); bfu* AOR = (bfu*)(ws + WS_AORAW); bfu* AO = (bfu*)(ws + WS_AO);
    bfu* UV = (bfu*)(ws + WS_UV); bfu* SB = (bfu*)(ws + WS_S); bfu* ZB = (bfu*)(ws + WS_ZB); bfu* ACT = (bfu*)(ws + WS_ACT);
    float* xlat = a.out;
    volatile LAS unsigned* bst = (volatile LAS unsigned*)(lds + LDS_BYTES - 64);
    if (threadIdx.x < 2) bst[threadIdx.x] = 0u;
    __syncthreads();
    const XcdBarrier xbar = xcd_barrier_post((unsigned*)(ws + WS_BAR), bst);
    if (threadIdx.x == 0) { const unsigned xc = xb_xcc_id() & 7u; bst[2] = xc; bst[3] = atomicAdd((unsigned*)(ws + WS_BAR) + 3500 + xc, 1u); }

    for (int rc_ = 0; rc_ < PROBE_CONV; ++rc_) p_mods(a.in[I_C], a.in[I_CCTX], a.in[I_ADAW], a.in[I_ADAB], mods, (LAS float*)lds, bx, G);
    for (int rc_ = 0; rc_ < PROBE_CONV; ++rc_) convert_weights(a.in[I_AWIN], DM, NQKV, wmixa, 0, lds, bx, G);
    for (int rc_ = 0; rc_ < PROBE_CONV; ++rc_) convert_weights(a.in[I_AWOUT], DM, DM, wmixb, 0, lds, bx, G);
    if (gridDim.x == 0x7fffffffu) grid.sync();
    GSYNC();
    int cid = bx, vcu = bx, xmap = 0;
    { bool even = (G % 8 == 0);
      for (int j = 0; j < 8; ++j) even = even && (__hip_atomic_load((unsigned*)(ws + WS_BAR) + 3500 + j, __ATOMIC_RELAXED, __HIP_MEMORY_SCOPE_AGENT) == (unsigned)(G / 8));
      if (even) { const int xc = (int)bst[2], rk = (int)bst[3]; cid = rk * 8 + xc; vcu = xc * (G / 8) + rk; xmap = (G == 256); }
      cid = __builtin_amdgcn_readfirstlane(cid); vcu = __builtin_amdgcn_readfirstlane(vcu); xmap = __builtin_amdgcn_readfirstlane(xmap); }

#pragma unroll 1
    for (int l = 0; l < 4; ++l) {
        int bxl = cid, Gl = G, vcul = vcu; asm volatile("" : "+s"(bxl), "+s"(Gl), "+s"(vcul));
        const int li = l >> 1; const bool is_attn = (l & 1) == 0; const bool upd_ctx = l < 2;
        const bool ctx_in = is_attn || upd_ctx;
        const float* mods_l = mods + (size_t)l * 3 * NMOD;
        const float lam_init = (l == 0) ? 0.2f : 0.47071302f;

        if (l == 0) p_norm<false>(a.in[I_X], a.in[I_CTX], nullptr, nullptr, a.in[I_MIXN], mods_l, 0, DM, H, true, bxl, Gl);
        else ELT(p_norm<false>(xlat, ctxx, nullptr, nullptr, a.in[I_MIXN] + l * DM, mods_l, 0, DM, H, ctx_in, bxl, Gl));
        for (int rc_ = 0; rc_ < PROBE_CONV; ++rc_) convert_weights(a.in[I_FUP] + (size_t)l * DM * 2 * FFN, DM, 2 * FFN, wup, 1, lds, bxl, Gl);
        for (int rc_ = 0; rc_ < PROBE_CONV; ++rc_) convert_weights(a.in[I_FDN] + (size_t)l * FFN * DM, FFN, DM, wdn, 0, lds, bxl, Gl);
        GSYNC();

        if (is_attn) {
            { pg8::Gemm g{H, wmixa, MROWS, NQKV, DM}; RowSched S; S.init(NQKV, Gl, bxl, 0);
              pg8::EpiBf16<0> E{QKV, NQKV, nullptr, 0, 0, 1.f};
              for (int rg_ = 0; rg_ < PROBE_GEMM; ++rg_) pg8::gemm_phase<pg8::EpiBf16<0>, RowSched, true, true>(lds, g, S, E); }
            GSYNC();
            p_qkvpost(QKV, a.in[I_QN] + li * 64, a.in[I_KN] + li * 64, bxl, Gl);
#ifdef PROBE_POST
            for (int rp_ = 0; rp_ < PROBE_POST; ++rp_) p_qkvpost(AOR, a.in[I_QN] + li * 64, a.in[I_KN] + li * 64, bxl, Gl);
#endif
            GSYNC();
            for (int rep_ = 0; rep_ < PROBE_ATTN; ++rep_) p_attn(QKV, AOR, AO, a.in[I_LQ1] + li * 64, a.in[I_LK1] + li * 64, a.in[I_LQ2] + li * 64, a.in[I_LK2] + li * 64, a.in[I_SUBLN] + li * 128, lam_init, upd_ctx, (char*)lds_raw, bxl, Gl, vcul, xmap);
            GSYNC();
        } else {
            { pg8::Gemm g{H, wmixa, MROWS, 2 * DM, DM}; RowSched S; S.init(2 * DM, Gl, bxl, !upd_ctx);
              EpiGeluV E{UV, rstd};
              pg8::gemm_phase<EpiGeluV, RowSched, true, true>(lds, g, S, E); }
            GSYNC();
            for (int rm_ = 0; rm_ < PROBE_MISC; ++rm_) p_sgu_mix(UV, rstd, a.in[I_SVN] + li * DM, wmixs, a.in[I_SBS] + li * 512, SB, upd_ctx, lds, bxl, Gl);
            GSYNC();
        }
        if (upd_ctx) p_ctx_resid<8>(is_attn ? AO : SB, DM, wmixb, l == 0 ? a.in[I_CTX] : ctxx, ctxx, mods_l + 2 * NMOD + 2 * DM, lds, bxl, Gl);
        { pg8::Gemm g{is_attn ? AO : SB, wmixb, MROWS, DM, DM}; RowSched S; S.init(DM, Gl, bxl, 1);
#ifdef PROBE_RES
          { EpiResid E2{xlat, ctxx, (float*)(ws + WS_BIG) + 512 * 1024, (float*)(ws + WS_BIG), mods_l + 2 * DM}; pg8::gemm_phase<EpiResid, RowSched, true, true>(lds, g, S, E2); }
#endif
          EpiResid E{l == 0 ? a.in[I_X] : xlat, l == 0 ? a.in[I_CTX] : ctxx, xlat, ctxx, mods_l + 2 * DM};
          pg8::gemm_phase<EpiResid, RowSched, true, true>(lds, g, S, E); }
        GSYNC();

        ELT(p_norm<false>(xlat, ctxx, nullptr, nullptr, a.in[I_FFNN] + l * DM, mods_l, 3 * DM, 4 * DM, H, upd_ctx, bxl, Gl));
        if (l < 3) {
            const int nl = l + 1, ni = nl >> 1;
            if ((nl & 1) == 0) {
                for (int rc_ = 0; rc_ < PROBE_CONV; ++rc_) convert_weights(a.in[I_AWIN] + (size_t)ni * DM * NQKV, DM, NQKV, wmixa, 0, lds, bxl, Gl);
                for (int rc_ = 0; rc_ < PROBE_CONV; ++rc_) convert_weights(a.in[I_AWOUT] + (size_t)ni * DM * DM, DM, DM, wmixb, 0, lds, bxl, Gl);
            } else {
                for (int rc_ = 0; rc_ < PROBE_CONV; ++rc_) convert_weights(a.in[I_SWIN] + (size_t)ni * DM * 2 * DM, DM, 2 * DM, wmixa, 0, lds, bxl, Gl);
                for (int rc_ = 0; rc_ < PROBE_CONV; ++rc_) convert_weights(a.in[I_SWOUT] + (size_t)ni * DM * DM, DM, DM, wmixb, 0, lds, bxl, Gl);
                const float* wsrc = a.in[I_SWS] + (size_t)ni * 65536;
                for (int e = bxl * NTHR + opaque_tid(); e < 32768; e += Gl * NTHR) ((unsigned*)wmixs)[e] = pk2(wsrc[2 * e], wsrc[2 * e + 1]);
            }
        }
        GSYNC();

        { pg8::Gemm g{H, wup, MROWS, 2 * FFN, DM}; RowSched S; S.init(2 * FFN, Gl, bxl, !upd_ctx);
          EpiConv E{ACT, ZB, a.in[I_FCW] + (size_t)l * 3 * 2 * FFN, a.in[I_FCB] + (size_t)l * 2 * FFN};
          pg8::gemm_phase<EpiConv, RowSched, true, true>(lds, g, S, E); }
        GSYNC();
        p_convfix(ZB, ACT, a.in[I_FCW] + (size_t)l * 3 * 2 * FFN, a.in[I_FCB] + (size_t)l * 2 * FFN, upd_ctx, bxl, Gl);
        GSYNC();
        if (upd_ctx) p_ctx_resid<11>(ACT, FFN, wdn, ctxx, ctxx, mods_l + 2 * NMOD + 5 * DM, lds, bxl, Gl);
        { pg8::Gemm g{ACT, wdn, MROWS, DM, FFN}; RowSched S; S.init(DM, Gl, bxl, 1);
#ifdef PROBE_RES
          { EpiResid E2{xlat, ctxx, (float*)(ws + WS_BIG) + 512 * 1024, (float*)(ws + WS_BIG), mods_l + 5 * DM}; pg8::gemm_phase<EpiResid, RowSched, true, true>(lds, g, S, E2); }
#endif
          EpiResid E{xlat, ctxx, xlat, ctxx, mods_l + 5 * DM};
          pg8::gemm_phase<EpiResid, RowSched, true, true>(lds, g, S, E); }
        GSYNC();
    }
    p_final(xlat, a.in[I_FINN], cid, G);
}

extern "C" void kernel_launch(void* const* d_in, const int* in_sizes, int n_in, void* d_out, int out_size, void* d_ws, size_t ws_size, hipStream_t stream) {
    static int grid = 0;
    if (grid == 0) {
        if (n_in != 27 || ws_size < WS_END) { fprintf(stderr, "kernel_launch: unexpected n_in %d / ws %zu\n", n_in, ws_size); grid = -1; return; }
        int dev = 0, cus = 0, per_cu = 0;
        (void)hipGetDevice(&dev);
        (void)hipDeviceGetAttribute(&cus, hipDeviceAttributeMultiprocessorCount, dev);
        if (hipFuncSetAttribute((const void*)fwd_megakernel, hipFuncAttributeMaxDynamicSharedMemorySize, LDS_BYTES) != hipSuccess) { fprintf(stderr, "kernel_launch: hipFuncSetAttribute failed\n"); grid = -1; return; }
        if (hipOccupancyMaxActiveBlocksPerMultiprocessor(&per_cu, (const void*)fwd_megakernel, NTHR, LDS_BYTES) != hipSuccess || per_cu < 1) { fprintf(stderr, "kernel_launch: occupancy query gave %d\n", per_cu); per_cu = 1; }
        (void)hipGetLastError();
        grid = cus * 1;
    }
    if (grid < 0) return;
    (void)hipMemsetAsync((char*)d_ws + WS_BAR, 0, BAR_BYTES, stream);
    Args a{};
    for (int i = 0; i < 27; ++i) a.in[i] = (const float*)d_in[i];
    a.out = (float*)d_out; a.ws = (unsigned char*)d_ws;
    void* args[] = {&a};
    hipError_t e = hipLaunchCooperativeKernel((const void*)fwd_megakernel, dim3(grid), dim3(NTHR), args, LDS_BYTES, stream);
    if (e != hipSuccess) fprintf(stderr, "cooperative launch failed: %s (grid %d)\n", hipGetErrorString(e), grid);
}
```
